# Optimizing an MI355X kernel written in HIP

```python
import jax, jax.numpy as jnp
from jax import lax
import numpy as np

D_MODEL = 2048
BATCH = 2
SEQ = 16384
DEPTH = 2
DEC_BATCH = 8
DEC_SEQ = 32
PAST_LEN = 1024

CHUNK = 64
N_MIXERS = 2
N_A = (DEPTH + 1) // 2
N_B = DEPTH // 2
D_MIXER = D_MODEL
CONV_W = 3
GMLP_CHUNK = 128
GMLP_GROUPS = 8
GMLP_GROUP_DIM = D_MIXER // GMLP_GROUPS
N_MEM = 256
XA_HEADS = 4
XA_HEAD_DIM = D_MODEL // 8
D_XQ = XA_HEADS * XA_HEAD_DIM
D_MIX = D_MIXER + D_XQ
D_FF = 5632
EPS = 1e-6

kernel_name = "hybrid_shortconv_gmlp_memxattn_convffn_step"


def rmsnorm(x, g):
    x32 = x.astype(jnp.float32)
    y = x32 * lax.rsqrt(jnp.mean(x32 * x32, axis=-1, keepdims=True) + EPS)
    return (y * g.astype(jnp.float32)).astype(x.dtype)


def layernorm(x, g, b):
    x32 = x.astype(jnp.float32)
    xc = x32 - jnp.mean(x32, axis=-1, keepdims=True)
    y = xc * lax.rsqrt(jnp.mean(xc * xc, axis=-1, keepdims=True) + EPS)
    return (y * g.astype(jnp.float32) + b.astype(jnp.float32)).astype(x.dtype)


def causal_dwconv(z, w, prev):
    T = z.shape[1]
    zp = jnp.concatenate([prev.astype(z.dtype), z], axis=1)
    y = w[0] * zp[:, :T]
    for k in range(1, CONV_W):
        y = y + w[k] * zp[:, k:k + T]
    return y, zp[:, -(CONV_W - 1):]


def short_conv_mixer(proj, conv_w, prev):
    b_gate, c_gate, h = jnp.split(proj, 3, axis=-1)
    y, buf = causal_dwconv(c_gate * h, conv_w, prev)
    return b_gate * y, buf


def chunk_mlp_mixer(proj, norm_g, norm_b, ws, bias):
    z = jax.nn.gelu(proj, approximate=False)
    u, v = jnp.split(z, 2, axis=-1)
    v = layernorm(v, norm_g, norm_b)
    B, T, _ = v.shape
    n_chunks = -(-T // GMLP_CHUNK)
    pad = n_chunks * GMLP_CHUNK - T
    vp = jnp.pad(v, ((0, 0), (0, pad), (0, 0))).reshape(
        B, n_chunks, GMLP_CHUNK, GMLP_GROUPS, GMLP_GROUP_DIM)
    mask = jnp.tril(jnp.ones((GMLP_CHUNK, GMLP_CHUNK), dtype=bool))
    wm = jnp.where(mask, ws, jnp.zeros((), ws.dtype)).astype(v.dtype)
    mixed = jnp.einsum('gts,bcsgd->bctgd', wm, vp) + jnp.swapaxes(bias, 0, 1)[:, :, None].astype(v.dtype)
    mixed = mixed.reshape(B, n_chunks * GMLP_CHUNK, D_MIXER)[:, :T]
    return u * mixed, v


def memory_kv(mem, g, wk, wv):
    B = mem.shape[0]
    mn = rmsnorm(mem, g)
    k = (mn @ wk).reshape(B, N_MEM, XA_HEADS, XA_HEAD_DIM)
    v = (mn @ wv).reshape(B, N_MEM, XA_HEADS, XA_HEAD_DIM)
    return k, v


def memory_attention(q, k, v):
    B, T, _ = q.shape
    q = q.reshape(B, T, XA_HEADS, XA_HEAD_DIM)
    s = jnp.einsum('bthd,bmhd->bhtm', q, k).astype(jnp.float32) * (XA_HEAD_DIM ** -0.5)
    p = jax.nn.softmax(s, axis=-1).astype(v.dtype)
    return jnp.einsum('bhtm,bmhd->bthd', p, v).reshape(B, T, D_XQ)


def trunk(x, mem_k, mem_v, conv_a_prev, ffn_prev, norm_mix_g, w_in_a, conv_a_w, w_in_b,
          gmlp_norm_g, gmlp_norm_b, gmlp_ws, gmlp_bias, w_out, norm_ffn_g, w_up,
          ffn_conv_w, ffn_conv_b, w_down, norm_final_g):
    conv_a_new, ffn_new, gmlp_v = [], [], []
    for i in range(DEPTH):
        kind, j = i % N_MIXERS, i // N_MIXERS
        xn = rmsnorm(x, norm_mix_g[i])
        if kind == 0:
            proj = xn @ w_in_a[j]
            y_mix, buf = short_conv_mixer(proj[..., :3 * D_MIXER], conv_a_w[j], conv_a_prev[j])
            conv_a_new.append(buf)
        else:
            proj = xn @ w_in_b[j]
            y_mix, v_rows = chunk_mlp_mixer(proj[..., :2 * D_MIXER], gmlp_norm_g[j],
                                            gmlp_norm_b[j], gmlp_ws[j], gmlp_bias[j])
            gmlp_v.append(v_rows)
        y_mem = memory_attention(proj[..., -D_XQ:], mem_k[i], mem_v[i])
        x = x + jnp.concatenate([y_mix, y_mem], axis=-1) @ w_out[i]
        xn = rmsnorm(x, norm_ffn_g[i])
        z, buf = causal_dwconv(xn @ w_up[i], ffn_conv_w[i], ffn_prev[i])
        a, g = jnp.split(z + ffn_conv_b[i], 2, axis=-1)
        x = x + (jax.nn.silu(g) * a) @ w_down[i]
        ffn_new.append(buf)
    return rmsnorm(x, norm_final_g), jnp.stack(conv_a_new), jnp.stack(ffn_new), jnp.stack(gmlp_v)


def setup_inputs(seed: int = 0) -> dict:
    key = jax.random.key(seed)
    ks = iter(jax.random.split(key, 32))
    f32 = jnp.float32

    def nrm(shape, scale=1.0):
        return jax.random.normal(next(ks), shape, f32) * scale

    def gain(shape):
        return 1.0 + 0.01 * jax.random.normal(next(ks), shape, f32)

    D = D_MODEL
    return {
        'x_prompt': nrm((BATCH, SEQ, D)),
        'x_sample': nrm((DEC_BATCH, DEC_SEQ, D)),
        'mem_prompt': nrm((BATCH, N_MEM, D)),
        'cache_conv_a': nrm((N_A, DEC_BATCH, CONV_W - 1, D_MIXER)),
        'cache_ffn_conv': nrm((DEPTH, DEC_BATCH, CONV_W - 1, 2 * D_FF)),
        'cache_mem_k': nrm((DEPTH, DEC_BATCH, N_MEM, XA_HEADS, XA_HEAD_DIM)),
        'cache_mem_v': nrm((DEPTH, DEC_BATCH, N_MEM, XA_HEADS, XA_HEAD_DIM)),
        'norm_mix_g': gain((DEPTH, D)),
        'norm_mem_g': gain((DEPTH, D)),
        'w_mem_k': nrm((DEPTH, D, D_XQ), D ** -0.5),
        'w_mem_v': nrm((DEPTH, D, D_XQ), D ** -0.5),
        'w_in_a': nrm((N_A, D, 3 * D_MIXER + D_XQ), D ** -0.5),
        'conv_a_w': nrm((N_A, CONV_W, D_MIXER), CONV_W ** -0.5),
        'w_in_b': nrm((N_B, D, 2 * D_MIXER + D_XQ), D ** -0.5),
        'gmlp_norm_g': gain((N_B, D_MIXER)),
        'gmlp_norm_b': nrm((N_B, D_MIXER), 0.01),
        'gmlp_ws': nrm((N_B, GMLP_GROUPS, GMLP_CHUNK, GMLP_CHUNK), GMLP_CHUNK ** -0.5),
        'gmlp_bias': gain((N_B, GMLP_GROUPS, GMLP_CHUNK)),
        'w_out': nrm((DEPTH, D_MIX, D), D_MIX ** -0.5),
        'norm_ffn_g': gain((DEPTH, D)),
        'w_up': nrm((DEPTH, D, 2 * D_FF), D ** -0.5),
        'ffn_conv_w': nrm((DEPTH, CONV_W, 2 * D_FF), CONV_W ** -0.5),
        'ffn_conv_b': nrm((DEPTH, 2 * D_FF), 0.01),
        'w_down': nrm((DEPTH, D_FF, D), D_FF ** -0.5),
        'norm_final_g': gain((D,)),
    }


def reference(x_prompt, x_sample, mem_prompt, cache_conv_a, cache_ffn_conv, cache_mem_k,
              cache_mem_v, norm_mix_g, norm_mem_g, w_mem_k, w_mem_v, w_in_a, conv_a_w,
              w_in_b, gmlp_norm_g, gmlp_norm_b, gmlp_ws, gmlp_bias, w_out, norm_ffn_g,
              w_up, ffn_conv_w, ffn_conv_b, w_down, norm_final_g):
    weights = (norm_mix_g, w_in_a, conv_a_w, w_in_b, gmlp_norm_g, gmlp_norm_b, gmlp_ws,
               gmlp_bias, w_out, norm_ffn_g, w_up, ffn_conv_w, ffn_conv_b, w_down, norm_final_g)

    B = x_prompt.shape[0]
    kv = [memory_kv(mem_prompt, norm_mem_g[i], w_mem_k[i], w_mem_v[i]) for i in range(DEPTH)]
    mem_k_prompt = jnp.stack([k for k, _ in kv])
    mem_v_prompt = jnp.stack([v for _, v in kv])
    conv_a_zero = jnp.zeros((N_A, B, CONV_W - 1, D_MIXER), x_prompt.dtype)
    ffn_zero = jnp.zeros((DEPTH, B, CONV_W - 1, 2 * D_FF), x_prompt.dtype)
    y_prompt, conv_a_prompt, ffn_conv_prompt, _ = trunk(
        x_prompt, mem_k_prompt, mem_v_prompt, conv_a_zero, ffn_zero, *weights)

    y_sample, conv_a_sample, ffn_conv_sample, gmlp_v_sample = trunk(
        x_sample, cache_mem_k, cache_mem_v, cache_conv_a, cache_ffn_conv, *weights)

    return (y_prompt, y_sample, conv_a_prompt, ffn_conv_prompt, mem_k_prompt, mem_v_prompt,
            conv_a_sample, ffn_conv_sample, gmlp_v_sample)
```

```cpp
#include <hip/hip_runtime.h>
#include <hip/hip_cooperative_groups.h>
#include <cstdio>
namespace cg = cooperative_groups;
#define REP_ATTN 1
#define REP_ELEM 1
#define REP_PREP 1
#define REP_GEMM 1
#define REP_SMALL 1
#define REP_SYNC 1
#define GEMM_ALIGN true
#define GEMM_SP2 true
#define STAGGER 1

#define XB_TMO      128
#define XB_XCNT(j)  (256  + 64 * (j))
#define XB_XSUB(j)  (1280 + 64 * (j))
#define XB_XGEN(j)  (2304 + 64 * (j))
#define XB_TOP      3328
#define XB_TOPGEN   3392
#define XCD_BAR_WORDS 3456
#define XB_SPIN_CAP (1u << 18)
#define LAS __attribute__((address_space(3)))

__device__ __forceinline__ unsigned xb_ld(unsigned* p)              { return __hip_atomic_load(p, __ATOMIC_RELAXED, __HIP_MEMORY_SCOPE_AGENT); }
__device__ __forceinline__ unsigned xb_add(unsigned* p, unsigned v) { return __hip_atomic_fetch_add(p, v, __ATOMIC_RELAXED, __HIP_MEMORY_SCOPE_AGENT); }
__device__ __forceinline__ unsigned xb_xcc_id() { return (unsigned)__builtin_amdgcn_s_getreg((3 << 11) | 20) & 0xFu; }
#define XB_SPIN(cond, bar) do { unsigned _sp = 0; while (cond) { __builtin_amdgcn_s_sleep(1); \
    if ((++_sp & 255u) == 0u) { if (xb_ld(&(bar)[XB_TMO])) break; if (_sp > XB_SPIN_CAP) { atomicAdd(&(bar)[XB_TMO], 1u); break; } } } } while (0)

struct XcdBarrier {
    unsigned* bar; unsigned x;
    volatile LAS unsigned* st;
};

__device__ __forceinline__ XcdBarrier xcd_barrier_post(unsigned* bar, volatile LAS unsigned* st) {
    XcdBarrier b; b.bar = bar; b.x = xb_xcc_id(); b.st = st;
    if (threadIdx.x == 0) (void)xb_add(&bar[XB_XCNT(b.x)], 1u);
    return b;
}
__device__ __forceinline__ void xcd_barrier_complete(unsigned* bar, unsigned x, unsigned& nloc, unsigned& nx) {
    const unsigned G = gridDim.x * gridDim.y * gridDim.z;
    unsigned sum, cnt, mine, sp = 0u;
    for (;;) {
        sum = 0u; cnt = 0u; mine = 0u;
#pragma unroll
        for (unsigned j = 0; j < 16; ++j) { const unsigned c = xb_ld(&bar[XB_XCNT(j)]); sum += c; cnt += (c > 0u) ? 1u : 0u; mine = (j == x) ? c : mine; }
        if (sum == G) break;
        __builtin_amdgcn_s_sleep(1);
        if ((++sp & 255u) == 0u) { if (xb_ld(&bar[XB_TMO])) break; if (sp > XB_SPIN_CAP) { atomicAdd(&bar[XB_TMO], 1u); break; } }
    }
    nloc = mine > 0u ? mine : 1u; nx = cnt > 0u ? cnt : 1u;
}

__device__ __forceinline__ void xcd_barrier(const XcdBarrier& b) {
    asm volatile("s_waitcnt vmcnt(0)" ::: "memory");
    __syncthreads();
    if (threadIdx.x == 0) {
        unsigned* bar = b.bar;
        __builtin_amdgcn_s_waitcnt(0);
        unsigned nloc = b.st[0], nx = b.st[1];
        if (nloc == 0u) { xcd_barrier_complete(bar, b.x, nloc, nx); b.st[0] = nloc; b.st[1] = nx; }
        const unsigned old = xb_add(&bar[XB_XSUB(b.x)], 1u);
        const unsigned gen = old / nloc;
        if (old + 1u == (gen + 1u) * nloc) {
            __builtin_amdgcn_fence(__ATOMIC_RELEASE, "agent");
            asm volatile("s_waitcnt vmcnt(0)" ::: "memory");
            const unsigned og = xb_add(&bar[XB_TOP], 1u);
            const unsigned tg = og / nx;
            if (og + 1u == (tg + 1u) * nx) xb_add(&bar[XB_TOPGEN], 1u);
            else XB_SPIN(xb_ld(&bar[XB_TOPGEN]) == tg, bar);
            __builtin_amdgcn_fence(__ATOMIC_ACQUIRE, "agent");
            xb_add(&bar[XB_XGEN(b.x)], 1u);
            asm volatile("s_waitcnt vmcnt(0)" ::: "memory");
        } else {
            XB_SPIN(xb_ld(&bar[XB_XGEN(b.x)]) == gen, bar);
            __builtin_amdgcn_fence(__ATOMIC_ACQUIRE, "agent");
            asm volatile("s_waitcnt vmcnt(0)" ::: "memory");
        }
    }
    __syncthreads();
}
namespace pg8 {
#define PG8_LAS __attribute__((address_space(3)))
typedef unsigned short bf16_t;
}
__device__ __forceinline__ int otid() { int t = threadIdx.x; asm volatile("" : "+v"(t)); return t; }
namespace pg8 {
typedef short bf16x8 __attribute__((ext_vector_type(8)));
typedef float f32x4 __attribute__((ext_vector_type(4)));
typedef unsigned u32x4 __attribute__((ext_vector_type(4)));
constexpr int BM = 256, BK = 64, HALF = 128, HTB = HALF * BK * 2  , STAGE_BYTES = 8 * HTB, NXCD = 8, WGM = 6;

__host__ __device__ __forceinline__ int lds_byte(int r, int c) { const int st = (r >> 4) * 2 + (c >> 5), rr = r & 15, cc = c & 31, ob = rr * 64 + cc * 2; return st * 1024 + (ob ^ (((ob >> 9) & 1) << 5)); }
__host__ __device__ __forceinline__ void stage_rc(int b, int& R, int& C) { const int st = b / 1024, sb = b % 1024, swz = sb ^ (((sb >> 9) & 1) << 5); R = (st >> 1) * 16 + swz / 64; C = (st & 1) * 32 + (swz % 64) / 2; }
__host__ __device__ __forceinline__ int perm32(int rho) { const int n = rho >> 4, i = rho & 15; return 8 * (i >> 2) + 4 * n + (i & 3); }

struct Unit { int pm, pn; };
struct Gemm { const bf16_t* A; const bf16_t* Bt; int M, N, K; };

struct StaticOrder {
    int nM, nN, nwg, G, c;
    __host__ __device__ void init(int M, int N, int G_, int c_) { nM = M / BM; nN = N / BM; nwg = nM * nN; G = G_; c = c_; }
    __host__ __device__ bool next(int i, Unit& u) const {
        const long L = (long)i * G + c; if (L >= nwg) return false;
        int wgid = (int)L; { const int q = nwg / NXCD, r = nwg % NXCD, xcd = wgid % NXCD, off = wgid / NXCD; wgid = (xcd < r ? xcd * (q + 1) : r * (q + 1) + (xcd - r) * q) + off; }
        const int nig = WGM * nN, gid = wgid / nig, fm = gid * WGM, gsz = (nM - fm) < WGM ? (nM - fm) : WGM;
        u.pm = fm + ((wgid % nig) % gsz); u.pn = (wgid % nig) / gsz; return true;
    }
    __device__ __forceinline__ void a_ready(const Unit&) const {}
    __device__ __forceinline__ void done(const Unit&) const {}
};
__device__ __forceinline__ unsigned cvt_pk_bf16(float lo, float hi) { unsigned r; asm volatile("v_cvt_pk_bf16_f32 %0, %1, %2" : "=v"(r) : "v"(lo), "v"(hi)); return r; }
typedef float f32x2 __attribute__((ext_vector_type(2)));
__device__ __forceinline__ f32x2 gelu_pk(f32x2 v) {
    const f32x2 av = __builtin_elementwise_abs(v), d = av * 0.2316418882f + 1.0f;
    f32x2 t; t.x = __builtin_amdgcn_rcpf(d.x); t.y = __builtin_amdgcn_rcpf(d.y);
    f32x2 q = t * 0.5307027145f + (-0.7265760135f); q = q * t + 0.7107068705f; q = q * t + (-0.142248368f); q = q * t + 0.127414796f; q = q * t;
    const f32x2 s = (v * v) * (-0.72134752044f);
    f32x2 e; e.x = __builtin_amdgcn_exp2f(s.x); e.y = __builtin_amdgcn_exp2f(s.y);
    const f32x2 m = v * (q * e), r = v - m;
    f32x2 o; o.x = v.x < 0.f ? m.x : r.x; o.y = v.y < 0.f ? m.y : r.y; return o;
}
template <class Epi, class Sched, bool ALIGN_EPI = false, bool SP2 = false>
__device__ __forceinline__ void gemm_phase(PG8_LAS unsigned char* lds, const Gemm g, const Sched& S, const Epi& E) {
    const int tid = otid(), wid = __builtin_amdgcn_readfirstlane(tid >> 6), lane = tid & 63, wr = wid >> 2, wc = wid & 3, fr = lane & 15, fq = lane >> 4;
    const int K = g.K, nt = K / BK;
    unsigned voffA[2], voffB[2];
#pragma unroll
    for (int i = 0; i < 2; ++i) { int R, C; stage_rc(tid * 16 + i * 8192, R, C); const int Rb = Epi::PERM ? ((R & ~31) + perm32(R & 31)) : R;
        const int Ra = Epi::APERM ? ((R & ~63) + 4 * (R & 15) + ((R >> 4) & 3)) : R;
        voffA[i] = (unsigned)(Ra * K + C) * 2u; voffB[i] = (unsigned)(Rb * K + C) * 2u; }
    const size_t kstep = (size_t)(BK * 2);
    const size_t hstep = (size_t)HALF * K * 2;
    const size_t tstep = 2 * hstep;
    const unsigned ldsw = (unsigned)wid * 1024u;
    const int aoff = lds_byte(wr * 64 + fr, fq * 8), boff = lds_byte(wc * 32 + fr, fq * 8);
#define PG8_SA(b, h) (((b) * 2 + (h)) * HTB)
#define PG8_SB(b, h) ((4 + (b) * 2 + (h)) * HTB)
#define PG8_STAGE(bufoff, gbase, voff) do { _Pragma("unroll") for (int _i = 0; _i < 2; ++_i) \
        __builtin_amdgcn_global_load_lds((const unsigned*)((const char*)(gbase) + (voff)[_i]), (PG8_LAS unsigned*)(lds + (bufoff) + ldsw + _i * 8192), 16, 0, 0); } while (0)
#define PG8_LDA(dst, b, h) do { _Pragma("unroll") for (int m = 0; m < 4; ++m) _Pragma("unroll") for (int k = 0; k < 2; ++k) dst[m][k] = *(const PG8_LAS bf16x8*)(lds + PG8_SA(b, h) + aoff + m * 2048 + k * 1024); } while (0)
#define PG8_LDB(dst, b, h) do { _Pragma("unroll") for (int n = 0; n < 2; ++n) _Pragma("unroll") for (int k = 0; k < 2; ++k) dst[n][k] = *(const PG8_LAS bf16x8*)(lds + PG8_SB(b, h) + boff + n * 2048 + k * 1024); } while (0)
#define PG8_MMA(ai, bj, At, Bt) do { __builtin_amdgcn_s_setprio(1); _Pragma("unroll") for (int m = 0; m < 4; ++m) _Pragma("unroll") for (int n = 0; n < 2; ++n) _Pragma("unroll") for (int k = 0; k < 2; ++k) \
        acc[ai][bj][m][n] = __builtin_amdgcn_mfma_f32_16x16x32_bf16(Bt[n][k], At[m][k], acc[ai][bj][m][n], 0, 0, 0); __builtin_amdgcn_s_setprio(0); } while (0)
#define PG8_WAIT_V(n) asm volatile("s_waitcnt vmcnt(" #n ")" ::: "memory")
#define PG8_WAIT_L(n) asm volatile("s_waitcnt lgkmcnt(" #n ")" ::: "memory")
#define PG8_BAR __builtin_amdgcn_s_barrier()
#define PG8_SCHED __builtin_amdgcn_sched_barrier(0)
    Unit cur, nxt; int ui = 0;
    if (!S.next(0, cur)) return;
    f32x4 acc[2][2][4][2];
#pragma unroll
    for (int a = 0; a < 2; ++a)
#pragma unroll
        for (int b = 0; b < 2; ++b)
#pragma unroll
            for (int m = 0; m < 4; ++m)
#pragma unroll
                for (int n = 0; n < 2; ++n) acc[a][b][m][n] = (f32x4){0.f, 0.f, 0.f, 0.f};
    bf16x8 At[4][2], B0[2][2], B1[2][2];
    const char* cA = (const char*)g.A + (size_t)cur.pm * tstep; const char* cB = (const char*)g.Bt + (size_t)cur.pn * tstep;
    S.a_ready(cur);
    if constexpr (SP2) {
        PG8_STAGE(PG8_SB(0, 0), cB, voffB); PG8_STAGE(PG8_SB(0, 1), cB + hstep, voffB); PG8_STAGE(PG8_SA(0, 0), cA, voffA); PG8_STAGE(PG8_SA(0, 1), cA + hstep, voffA);
        if (wr == 1) PG8_BAR;
        PG8_WAIT_V(2); PG8_BAR;
        PG8_STAGE(PG8_SB(1, 0), cB + kstep, voffB); PG8_STAGE(PG8_SA(1, 0), cA + kstep, voffA); PG8_STAGE(PG8_SB(1, 1), cB + hstep + kstep, voffB);
        PG8_WAIT_V(6); PG8_BAR;
    } else {
        PG8_STAGE(PG8_SB(0, 0), cB, voffB); PG8_STAGE(PG8_SA(0, 0), cA, voffA); PG8_STAGE(PG8_SB(0, 1), cB + hstep, voffB); PG8_STAGE(PG8_SA(0, 1), cA + hstep, voffA);
        if (wr == 1) PG8_BAR;
        PG8_WAIT_V(4); PG8_BAR;
        PG8_STAGE(PG8_SB(1, 0), cB + kstep, voffB); PG8_STAGE(PG8_SA(1, 0), cA + kstep, voffA); PG8_STAGE(PG8_SB(1, 1), cB + hstep + kstep, voffB);
        PG8_WAIT_V(6); PG8_BAR;
    }
    for (;;) {
        const bool has_next = S.next(ui + 1, nxt);
        const char* nA = has_next ? (const char*)g.A + (size_t)nxt.pm * tstep : cA; const char* nB = has_next ? (const char*)g.Bt + (size_t)nxt.pn * tstep : cB;
        for (int t = 0; t < nt; t += 2) {
            const bool last = (t == nt - 2);
            const char* a1 = cA + (size_t)(t + 1) * kstep;
            const char* a2 = last ? nA : cA + (size_t)(t + 2) * kstep; const char* b2 = last ? nB : cB + (size_t)(t + 2) * kstep;
            const char* a3 = a2 + kstep; const char* b3 = b2 + kstep;
            if (last && has_next) S.a_ready(nxt);
            if constexpr (SP2) {
            PG8_LDB(B0, 0, 0); PG8_LDB(B1, 0, 1); PG8_SCHED; PG8_LDA(At, 0, 0); PG8_STAGE(PG8_SA(1, 1), a1 + hstep, voffA);
            PG8_WAIT_V(8); PG8_WAIT_L(0); PG8_BAR; PG8_MMA(0, 0, At, B0); PG8_MMA(0, 1, At, B1); PG8_BAR; PG8_SCHED;
            PG8_LDA(At, 0, 1); PG8_STAGE(PG8_SB(0, 0), b2, voffB); PG8_STAGE(PG8_SB(0, 1), b2 + hstep, voffB); PG8_STAGE(PG8_SA(0, 0), a2, voffA);
            PG8_WAIT_V(8); PG8_WAIT_L(0); PG8_BAR; PG8_MMA(1, 0, At, B0); PG8_MMA(1, 1, At, B1); PG8_BAR; PG8_SCHED;
            PG8_LDB(B0, 1, 0); PG8_LDB(B1, 1, 1); PG8_SCHED; PG8_LDA(At, 1, 0); PG8_STAGE(PG8_SA(0, 1), a2 + hstep, voffA);
            PG8_WAIT_V(8); PG8_WAIT_L(0); PG8_BAR; PG8_MMA(0, 0, At, B0); PG8_MMA(0, 1, At, B1); PG8_BAR; PG8_SCHED;
            PG8_LDA(At, 1, 1); PG8_STAGE(PG8_SB(1, 0), b3, voffB); PG8_STAGE(PG8_SB(1, 1), b3 + hstep, voffB); PG8_STAGE(PG8_SA(1, 0), a3, voffA);
            PG8_WAIT_V(8); PG8_WAIT_L(0); PG8_BAR; PG8_MMA(1, 0, At, B0); PG8_MMA(1, 1, At, B1); PG8_BAR; PG8_SCHED;
            } else {
            PG8_LDB(B0, 0, 0); PG8_SCHED; PG8_LDA(At, 0, 0); PG8_STAGE(PG8_SA(1, 1), a1 + hstep, voffA);
            PG8_WAIT_L(8); PG8_BAR; PG8_WAIT_L(0); PG8_MMA(0, 0, At, B0); PG8_BAR; PG8_SCHED;
            PG8_LDB(B1, 0, 1); PG8_STAGE(PG8_SB(0, 0), b2, voffB);
            PG8_BAR; PG8_WAIT_L(0); PG8_MMA(0, 1, At, B1); PG8_BAR;
            PG8_LDA(At, 0, 1); PG8_STAGE(PG8_SA(0, 0), a2, voffA);
            PG8_BAR; PG8_WAIT_L(0); PG8_MMA(1, 0, At, B0); PG8_BAR; PG8_SCHED;
            PG8_STAGE(PG8_SB(0, 1), b2 + hstep, voffB);
            PG8_WAIT_V(6); PG8_BAR; PG8_MMA(1, 1, At, B1); PG8_BAR;
            PG8_LDB(B0, 1, 0); PG8_SCHED; PG8_LDA(At, 1, 0); PG8_STAGE(PG8_SA(0, 1), a2 + hstep, voffA);
            PG8_WAIT_L(8); PG8_BAR; PG8_WAIT_L(0); PG8_MMA(0, 0, At, B0); PG8_BAR; PG8_SCHED;
            PG8_LDB(B1, 1, 1); PG8_STAGE(PG8_SB(1, 0), b3, voffB);
            PG8_BAR; PG8_WAIT_L(0); PG8_MMA(0, 1, At, B1); PG8_BAR;
            PG8_LDA(At, 1, 1); PG8_STAGE(PG8_SA(1, 0), a3, voffA);
            PG8_BAR; PG8_WAIT_L(0); PG8_MMA(1, 0, At, B0); PG8_BAR; PG8_SCHED;
            PG8_STAGE(PG8_SB(1, 1), b3 + hstep, voffB);
            PG8_WAIT_V(6); PG8_BAR; PG8_MMA(1, 1, At, B1); PG8_BAR;
            }
        }
        if constexpr (ALIGN_EPI) { if (wr == 0) PG8_BAR; }
        if constexpr (!Epi::AFTER_DRAIN) { E(acc, cur, wr, wc, fr, fq); S.done(cur); }
        if (!has_next) break;
#pragma unroll
        for (int a = 0; a < 2; ++a)
#pragma unroll
            for (int b = 0; b < 2; ++b)
#pragma unroll
                for (int m = 0; m < 4; ++m)
#pragma unroll
                    for (int n = 0; n < 2; ++n) acc[a][b][m][n] = (f32x4){0.f, 0.f, 0.f, 0.f};
        cur = nxt; cA = nA; cB = nB; ++ui;
        if constexpr (ALIGN_EPI) { if (wr == 1) PG8_BAR; }
    }
    PG8_WAIT_V(0);
    if constexpr (!ALIGN_EPI) { if (wr == 0) PG8_BAR; }
    PG8_BAR;
    if constexpr (Epi::AFTER_DRAIN) { E.fused(acc, cur, wr, wc, fr, fq, lds, wid, lane); S.done(cur); }
#undef PG8_SA
#undef PG8_SB
#undef PG8_STAGE
#undef PG8_LDA
#undef PG8_LDB
#undef PG8_MMA
#undef PG8_WAIT_V
#undef PG8_WAIT_L
#undef PG8_BAR
#undef PG8_SCHED
}
}

using pg8::bf16_t; using pg8::bf16x8; using pg8::f32x4; using pg8::Unit; using pg8::f32x2; using pg8::u32x4;
typedef unsigned u32x2 __attribute__((ext_vector_type(2)));

constexpr int D = 2048, NPROMPT = 32768, NSAMP = 256, NROWS = 33024;
constexpr int NA = 7168, NB = 5120, DMIX = 3072, DFF = 5632, DFF2 = 11264;
constexpr int CH = 16384, CHL = CH + NSAMP;
constexpr float EPS = 1e-6f;
constexpr int LDS_BYTES = pg8::STAGE_BYTES + 16;

constexpr size_t WS_WINA = 0;
constexpr size_t WS_WINB = WS_WINA + (size_t)NA * D * 2;
constexpr size_t WS_WOUT = WS_WINB + (size_t)NB * D * 2;
constexpr size_t WS_WUP = WS_WOUT + (size_t)2 * D * DMIX * 2;
constexpr size_t WS_WDOWN = WS_WUP + (size_t)2 * DFF2 * D * 2;
constexpr size_t WS_WMEM = WS_WDOWN + (size_t)2 * D * DFF * 2;
constexpr size_t WS_WM = WS_WMEM + (size_t)4096 * D * 2;
constexpr size_t WS_XB = WS_WM + (size_t)8 * 128 * 128 * 2;
constexpr size_t WS_MEMB = WS_XB + (size_t)NROWS * D * 2;
constexpr size_t WS_KB = WS_MEMB + (size_t)512 * D * 2;
constexpr size_t WS_VT = WS_KB + (size_t)20 * 256 * 1024 * 2;
constexpr size_t WS_SS = WS_VT + (size_t)20 * 256 * 1024 * 2;
constexpr size_t WS_SSM = WS_SS + (size_t)NROWS * 32 * 4;
constexpr size_t WS_STATS = WS_SSM + (size_t)512 * 32 * 4;
constexpr size_t WS_BAR = WS_STATS + (size_t)NROWS * 8;
constexpr size_t WS_BIG = WS_BAR + 16384;
static_assert(XCD_BAR_WORDS * 4 <= 16384, "barrier words");
constexpr size_t BIG_PROJ = 0, BIG_YCAT = (size_t)CHL * NA * 2, BIG_ZS = BIG_YCAT + (size_t)NROWS * DMIX * 2, BIG_HALO = BIG_ZS + (size_t)NSAMP * DFF2 * 2, BIG_H = 0;
constexpr size_t WS_END = WS_BIG + BIG_HALO + (size_t)(NPROMPT / 64) * 4 * DFF2 * 4;
static_assert((size_t)NROWS * DFF * 2 <= BIG_ZS, "h overlays proj and ycat only");
static_assert(WS_END <= ((size_t)1 << 30), "workspace over 1 GiB");

constexpr size_t O_YP = 0, O_YS = 67108864, O_CAP = 67633152, O_FCP = 67641344, O_MKP = 67731456, O_MVP = 68780032, O_CAS = 69828608, O_FCS = 69861376, O_GVS = 70221824;

struct Params { const float* in[25]; float* out; unsigned char* ws; };
enum { I_XP = 0, I_XS, I_MEM, I_CCA, I_CFC, I_CMK, I_CMV, I_GMIX, I_GMEM, I_WMK, I_WMV, I_WINA, I_CAW, I_WINB, I_GNG, I_GNB, I_GWS, I_GBIAS, I_WOUT, I_GFFN, I_WUP, I_FCW, I_FCB, I_WDOWN, I_GFIN };

__device__ __forceinline__ float bf_lo(unsigned u) { return __uint_as_float(u << 16); }
__device__ __forceinline__ float bf_hi(unsigned u) { return __uint_as_float(u & 0xffff0000u); }
__device__ __forceinline__ unsigned pk(float a, float b) { return pg8::cvt_pk_bf16(a, b); }
__device__ __forceinline__ void unpack8(const u32x4 r, float (&f)[8]) { f[0] = bf_lo(r.x); f[1] = bf_hi(r.x); f[2] = bf_lo(r.y); f[3] = bf_hi(r.y); f[4] = bf_lo(r.z); f[5] = bf_hi(r.z); f[6] = bf_lo(r.w); f[7] = bf_hi(r.w); }
__device__ __forceinline__ u32x4 pack8(const float (&f)[8]) { u32x4 w; w.x = pk(f[0], f[1]); w.y = pk(f[2], f[3]); w.z = pk(f[4], f[5]); w.w = pk(f[6], f[7]); return w; }
__device__ __forceinline__ int lrow(int row, int rows0) { return row < NPROMPT ? row - rows0 : row - NPROMPT + CH; }

template <int X1, int X2> __device__ __forceinline__ float rowscale(const float* ss, int row, int part) {
    const f32x4* q = (const f32x4*)(ss + (size_t)row * 32 + part * 8);
    const f32x4 a = q[0], b = q[1];
    float s = ((a[0] + a[1]) + (a[2] + a[3])) + ((b[0] + b[1]) + (b[2] + b[3]));
    s += __shfl_xor(s, X1); s += __shfl_xor(s, X2);
    return rsqrtf(s * (1.0f / 2048.0f) + EPS);
}

struct OpScale {
    static constexpr bool SUMSQ = false, NEEDS_RS = true, PRELOAD = false;
    const float* ss; bf16_t* dst; int ld, rows0, gelu_cols;
    struct Row { bf16_t* dp; float rs; bool gelu; };
    __device__ __forceinline__ const float* ssin() const { return ss; }
    __device__ __forceinline__ Row begin_row(int row, int col0, float rs) const { Row r; r.rs = rs; r.dp = dst + (size_t)lrow(row, rows0) * ld + col0; r.gelu = col0 < gelu_cols; return r; }
    __device__ __forceinline__ f32x4 load4(const Row&, int) const { return (f32x4){0.f, 0.f, 0.f, 0.f}; }
    __device__ __forceinline__ f32x4 act(const Row& r, f32x4 v) const {
        v = v * r.rs;
        if (r.gelu) { const f32x2 a = pg8::gelu_pk((f32x2){v[0], v[1]}), b = pg8::gelu_pk((f32x2){v[2], v[3]}); v = (f32x4){a.x, a.y, b.x, b.y}; }
        return v;
    }
    __device__ __forceinline__ void store4(const Row& r, int coff, f32x4 v, f32x4, float&) const {
        v = act(r, v); u32x2 w; w.x = pk(v[0], v[1]); w.y = pk(v[2], v[3]);
        *(u32x2*)(r.dp + coff) = w;
    }
    __device__ __forceinline__ void store8(const Row& r, int coff, f32x4 v0, f32x4 v1, f32x4, f32x4, float&) const {
        v0 = act(r, v0); v1 = act(r, v1); u32x4 w; w.x = pk(v0[0], v0[1]); w.y = pk(v0[2], v0[3]); w.z = pk(v1[0], v1[1]); w.w = pk(v1[2], v1[3]);
        *(u32x4*)(r.dp + coff) = w;
    }
    __device__ __forceinline__ void end_row(int, int, float) const {}
};
struct OpResid {
    static constexpr bool SUMSQ = true, NEEDS_RS = false, PRELOAD = true;
    bf16_t* xb; float* ss;
    struct Row { unsigned xo; };
    __device__ __forceinline__ const float* ssin() const { return nullptr; }
    __device__ __forceinline__ Row begin_row(int row, int col0, float) const { Row r; r.xo = (unsigned)row * D + col0; return r; }
    __device__ __forceinline__ f32x4 load4(const Row& r, int coff) const { const u32x2 w = *(const u32x2*)(xb + (size_t)r.xo + coff); return (f32x4){bf_lo(w.x), bf_hi(w.x), bf_lo(w.y), bf_hi(w.y)}; }
    __device__ __forceinline__ void store4(const Row& r, int coff, f32x4 v, f32x4 pre, float& sq) const {
        const f32x4 x = pre + v;
        u32x2 w; w.x = pk(x[0], x[1]); w.y = pk(x[2], x[3]);
        *(u32x2*)(xb + (size_t)r.xo + coff) = w;
        sq += (x[0] * x[0] + x[1] * x[1]) + (x[2] * x[2] + x[3] * x[3]);
    }
    __device__ __forceinline__ void store8(const Row& r, int coff, f32x4 v0, f32x4 v1, f32x4 p0, f32x4 p1, float& sq) const {
        const f32x4 x0 = p0 + v0, x1 = p1 + v1;
        u32x4 w; w.x = pk(x0[0], x0[1]); w.y = pk(x0[2], x0[3]); w.z = pk(x1[0], x1[1]); w.w = pk(x1[2], x1[3]);
        *(u32x4*)(xb + (size_t)r.xo + coff) = w;
        sq += ((x0[0] * x0[0] + x0[1] * x0[1]) + (x0[2] * x0[2] + x0[3] * x0[3])) + ((x1[0] * x1[0] + x1[1] * x1[1]) + (x1[2] * x1[2] + x1[3] * x1[3]));
    }
    __device__ __forceinline__ void end_row(int row, int part, float sq) const { ss[(size_t)row * 32 + part] = sq; }
};
struct OpMemKV {
    static constexpr bool SUMSQ = false, NEEDS_RS = true, PRELOAD = false;
    const float* ssm; float* out_k; float* out_v; bf16_t* Kb; bf16_t* Vt;
    struct Row { float* o; bf16_t* kb; bf16_t* vt; float rs; };
    __device__ __forceinline__ const float* ssin() const { return ssm; }
    __device__ __forceinline__ Row begin_row(int row, int col0, float rs) const {
        Row r; r.rs = rs;
        const int layer = col0 >> 11, isv = (col0 >> 10) & 1, c = col0 & 1023, b = row >> 8, m = row & 255, bbi = layer * 10 + 8 + b;
        r.o = (isv ? out_v : out_k) + ((size_t)((layer * 2 + b) * 256 + m)) * 1024 + c;
        r.kb = isv ? nullptr : Kb + ((size_t)bbi * 256 + m) * 1024 + c;
        r.vt = Vt + ((size_t)bbi * 1024 + c) * 256 + m;
        return r;
    }
    __device__ __forceinline__ f32x4 load4(const Row&, int) const { return (f32x4){0.f, 0.f, 0.f, 0.f}; }
    __device__ __forceinline__ void store4(const Row& r, int coff, f32x4 v, f32x4, float&) const {
        v = v * r.rs;
        *(f32x4*)(r.o + coff) = v;
        const unsigned w0 = pk(v[0], v[1]), w1 = pk(v[2], v[3]);
        if (r.kb) { u32x2 w; w.x = w0; w.y = w1; *(u32x2*)(r.kb + coff) = w; }
        else { bf16_t* t = r.vt + (size_t)coff * 256; t[0] = (bf16_t)(w0 & 0xffffu); t[256] = (bf16_t)(w0 >> 16); t[512] = (bf16_t)(w1 & 0xffffu); t[768] = (bf16_t)(w1 >> 16); }
    }
    __device__ __forceinline__ void end_row(int, int, float) const {}
};

template <class Op> struct EpiG {
    static constexpr bool PERM = true, APERM = false, AFTER_DRAIN = false;
    Op op; int row_base;
    __device__ __forceinline__ void operator()(const f32x4 (&acc)[2][2][4][2], const Unit& u, int wr, int wc, int fr, int fq) const {
        const int row0 = row_base + u.pm * 256 + wr * 64 + fr, col0 = u.pn * 256 + wc * 32 + 8 * fq;
        float rs[8];
        if constexpr (Op::NEEDS_RS) {
            const float* sp = op.ssin() + (size_t)row0 * 32 + fq * 8;
            f32x4 pa[8], pb[8];
#pragma unroll
            for (int i = 0; i < 8; ++i) { const float* q = sp + (size_t)((i >> 2) * 128 + (i & 3) * 16) * 32; pa[i] = *(const f32x4*)q; pb[i] = *(const f32x4*)(q + 4); }
#pragma unroll
            for (int i = 0; i < 8; ++i) { float s = ((pa[i][0] + pa[i][1]) + (pa[i][2] + pa[i][3])) + ((pb[i][0] + pb[i][1]) + (pb[i][2] + pb[i][3]));
                s += __shfl_xor(s, 16); s += __shfl_xor(s, 32); rs[i] = rsqrtf(s * (1.0f / 2048.0f) + EPS); }
        } else {
#pragma unroll
            for (int i = 0; i < 8; ++i) rs[i] = 1.f;
        }
        if constexpr (Op::PRELOAD) {
#pragma unroll
            for (int ai = 0; ai < 2; ++ai) {
                typename Op::Row rc[4]; f32x4 pre[4][4];
#pragma unroll
                for (int m = 0; m < 4; ++m) rc[m] = op.begin_row(row0 + ai * 128 + m * 16, col0, rs[ai * 4 + m]);
#pragma unroll
                for (int m = 0; m < 4; ++m)
#pragma unroll
                    for (int bj = 0; bj < 2; ++bj) { pre[m][bj * 2] = op.load4(rc[m], bj * 128); pre[m][bj * 2 + 1] = op.load4(rc[m], bj * 128 + 4); }
#pragma unroll
                for (int m = 0; m < 4; ++m) {
                    float sq = 0.f;
#pragma unroll
                    for (int bj = 0; bj < 2; ++bj) op.store8(rc[m], bj * 128, acc[ai][bj][m][0], acc[ai][bj][m][1], pre[m][bj * 2], pre[m][bj * 2 + 1], sq);
                    if (Op::SUMSQ) { sq += __shfl_xor(sq, 16); sq += __shfl_xor(sq, 32); if (fq == 0) op.end_row(row0 + ai * 128 + m * 16, u.pn * 4 + wc, sq); }
                }
                asm volatile("" ::: "memory");
            }
        } else {
            const f32x4 z4 = (f32x4){0.f, 0.f, 0.f, 0.f};
#pragma unroll
            for (int ai = 0; ai < 2; ++ai)
#pragma unroll
                for (int m = 0; m < 4; ++m) {
                    const typename Op::Row rc = op.begin_row(row0 + ai * 128 + m * 16, col0, rs[ai * 4 + m]); float sq = 0.f;
#pragma unroll
                    for (int bj = 0; bj < 2; ++bj) op.store8(rc, bj * 128, acc[ai][bj][m][0], acc[ai][bj][m][1], z4, z4, sq);
                }
        }
    }
};

__device__ __forceinline__ float dpp_shr1(float v) { return __builtin_bit_cast(float, __builtin_amdgcn_update_dpp(0, __builtin_bit_cast(int, v), 0x111, 0xf, 0xf, true)); }
struct EpiFfn {
    static constexpr bool PERM = true, APERM = true, AFTER_DRAIN = false;
    const float* ss; const float* cw; const float* cb; bf16_t* h; float* halo; int row_base;
    __device__ __forceinline__ void operator()(const f32x4 (&acc)[2][2][4][2], const Unit& u, int wr, int wc, int fr, int fq) const {
        const int lrow0 = u.pm * 256 + wr * 64 + 4 * fr, c0 = u.pn * 128 + wc * 32 + 8 * fq;
        float rs[8];
        {
            const float* sp = ss + (size_t)(row_base + lrow0) * 32 + fq * 8;
            f32x4 pa[8], pb[8];
#pragma unroll
            for (int i = 0; i < 8; ++i) { const float* q = sp + (size_t)((i >> 2) * 128 + (i & 3)) * 32; pa[i] = *(const f32x4*)q; pb[i] = *(const f32x4*)(q + 4); }
#pragma unroll
            for (int i = 0; i < 8; ++i) { float s = ((pa[i][0] + pa[i][1]) + (pa[i][2] + pa[i][3])) + ((pb[i][0] + pb[i][1]) + (pb[i][2] + pb[i][3]));
                s += __shfl_xor(s, 16); s += __shfl_xor(s, 32); rs[i] = rsqrtf(s * (1.0f / 2048.0f) + EPS); }
        }
        u32x2 res[8];
#pragma unroll
        for (int n = 0; n < 2; ++n) {
            const int cc = c0 + 4 * n;
            const f32x4 wa0 = *(const f32x4*)(cw + cc), wa1 = *(const f32x4*)(cw + DFF2 + cc), wa2 = *(const f32x4*)(cw + 2 * DFF2 + cc), ba = *(const f32x4*)(cb + cc);
            const f32x4 wg0 = *(const f32x4*)(cw + DFF + cc), wg1 = *(const f32x4*)(cw + DFF2 + DFF + cc), wg2 = *(const f32x4*)(cw + 2 * DFF2 + DFF + cc), bg = *(const f32x4*)(cb + DFF + cc);
#pragma unroll
            for (int ai = 0; ai < 2; ++ai) {
                const int blk = u.pm * 4 + ai * 2 + wr;
                f32x4 za[4], zg[4];
#pragma unroll
                for (int m = 0; m < 4; ++m) { za[m] = acc[ai][0][m][n] * rs[ai * 4 + m]; zg[m] = acc[ai][1][m][n] * rs[ai * 4 + m]; }
                f32x4 la2, la3, lg2, lg3;
#pragma unroll
                for (int j = 0; j < 4; ++j) { la2[j] = dpp_shr1(za[2][j]); la3[j] = dpp_shr1(za[3][j]); lg2[j] = dpp_shr1(zg[2][j]); lg3[j] = dpp_shr1(zg[3][j]); }
#pragma unroll
                for (int m = 0; m < 4; ++m) {
                    const f32x4 p2a = m == 0 ? la2 : (m == 1 ? la3 : za[m >= 2 ? m - 2 : 0]), p1a = m == 0 ? la3 : za[m >= 1 ? m - 1 : 0];
                    const f32x4 p2g = m == 0 ? lg2 : (m == 1 ? lg3 : zg[m >= 2 ? m - 2 : 0]), p1g = m == 0 ? lg3 : zg[m >= 1 ? m - 1 : 0];
                    const f32x4 ca = wa0 * p2a + wa1 * p1a + wa2 * za[m] + ba;
                    const f32x4 cg = wg0 * p2g + wg1 * p1g + wg2 * zg[m] + bg;
                    f32x4 o;
#pragma unroll
                    for (int j = 0; j < 4; ++j) o[j] = ca[j] * cg[j] * __builtin_amdgcn_rcpf(1.0f + __builtin_amdgcn_exp2f(-1.44269504089f * cg[j]));
                    if ((fr == 0 && m < 2) || (fr == 15 && m >= 2)) { float* hp = halo + ((size_t)(blk * 4 + m)) * DFF2 + cc; *(f32x4*)hp = za[m]; *(f32x4*)(hp + DFF) = zg[m]; }
                    u32x2 w; w.x = pk(o[0], o[1]); w.y = pk(o[2], o[3]);
                    if (n == 0) res[ai * 4 + m] = w;
                    else { u32x4 w4; w4.x = res[ai * 4 + m].x; w4.y = res[ai * 4 + m].y; w4.z = w.x; w4.w = w.y; *(u32x4*)(h + (size_t)(lrow0 + ai * 128 + m) * DFF + c0) = w4; }
                }
            }
        }
    }
};

constexpr int RP = 68;
template <class Op>
__device__ __forceinline__ void small_gemm(const bf16_t* A, int lda, const bf16_t* Bt, int M, int N, int K, const Op& op, int row_base, unsigned char* shm) {
    const int tid = otid(), lane = tid & 63, wid = tid >> 6, fr = lane & 15, fq = lane >> 4;
    float* red = (float*)shm;
    const int nmt = M / 32, ntiles = nmt * (N / 64), kw = K / 8;
    for (int t = blockIdx.x; t < ntiles; t += gridDim.x) {
        const int tm = t % nmt, tn = t / nmt;
        const bf16_t* ap = A + (size_t)(tm * 32 + fr) * lda + wid * kw + fq * 8;
        const bf16_t* bp = Bt + (size_t)(tn * 64 + fr) * K + wid * kw + fq * 8;
        f32x4 acc[2][4];
#pragma unroll
        for (int mt = 0; mt < 2; ++mt)
#pragma unroll
            for (int n = 0; n < 4; ++n) acc[mt][n] = (f32x4){0.f, 0.f, 0.f, 0.f};
#pragma unroll 4
        for (int k = 0; k < kw; k += 32) {
            const bf16x8 a0 = *(const bf16x8*)(ap + k), a1 = *(const bf16x8*)(ap + (size_t)16 * lda + k);
#pragma unroll
            for (int n = 0; n < 4; ++n) { const bf16x8 b = *(const bf16x8*)(bp + (size_t)n * 16 * K + k);
                acc[0][n] = __builtin_amdgcn_mfma_f32_16x16x32_bf16(b, a0, acc[0][n], 0, 0, 0); acc[1][n] = __builtin_amdgcn_mfma_f32_16x16x32_bf16(b, a1, acc[1][n], 0, 0, 0); }
        }
#pragma unroll
        for (int mt = 0; mt < 2; ++mt)
#pragma unroll
            for (int n = 0; n < 4; ++n) *(f32x4*)(red + (wid * 32 + mt * 16 + fr) * RP + n * 16 + 4 * fq) = acc[mt][n];
        __syncthreads();
        const int rl = wid * 4 + (lane >> 4), c4 = (lane & 15) * 4;
        f32x4 v = *(const f32x4*)(red + rl * RP + c4);
#pragma unroll
        for (int w = 1; w < 8; ++w) v += *(const f32x4*)(red + (w * 32 + rl) * RP + c4);
        const int row = row_base + tm * 32 + rl;
        float rs = 1.f; if (Op::NEEDS_RS) rs = rowscale<1, 2>(op.ssin(), row, lane & 3);
        const typename Op::Row rc = op.begin_row(row, tn * 64 + c4, rs); float sq = 0.f;
        f32x4 pre = (f32x4){0.f, 0.f, 0.f, 0.f}; if (Op::PRELOAD) pre = op.load4(rc, 0);
        op.store4(rc, 0, v, pre, sq);
        if (Op::SUMSQ) { sq += __shfl_xor(sq, 1); sq += __shfl_xor(sq, 2); sq += __shfl_xor(sq, 4); sq += __shfl_xor(sq, 8); if ((lane & 15) == 0) op.end_row(row, tn, sq); }
        __syncthreads();
    }
}

__device__ __forceinline__ int up_perm(int n) { return n < DFF ? (n >> 7) * 256 + (n & 127) : ((n - DFF) >> 7) * 256 + 128 + ((n - DFF) & 127); }
__device__ __forceinline__ void tjob(const float* src, const float* gain, bf16_t* dst, int K, int N, int nb, size_t sbs, size_t dbs, int& tile0, float* lf, bool perm = false) {
    const int tid = otid(), G = gridDim.x;
    const int nkt = K / 256, nnt = N / 64, tpb = nkt * nnt, ntile = tpb * nb;
    int first = ((int)blockIdx.x - tile0) % G; if (first < 0) first += G;
    for (int tt = first; tt < ntile; tt += G) {
        const int batch = tt / tpb, rem = tt % tpb, kt = rem % nkt, nt = rem / nkt;
        const float* s = src + (size_t)batch * sbs + (size_t)(kt * 256) * N + nt * 64;
        f32x4 v[8];
#pragma unroll
        for (int i = 0; i < 8; ++i) { const int idx = tid + 512 * i, kr = idx >> 4, c4 = idx & 15; v[i] = *(const f32x4*)(s + (size_t)kr * N + c4 * 4); }
#pragma unroll
        for (int i = 0; i < 8; ++i) {
            const int idx = tid + 512 * i, kr = idx >> 4, c4 = idx & 15;
            const float gk = gain ? gain[kt * 256 + kr] : 1.0f;
            float* l = lf + kr * 65 + c4 * 4; l[0] = v[i][0] * gk; l[1] = v[i][1] * gk; l[2] = v[i][2] * gk; l[3] = v[i][3] * gk;
        }
        __syncthreads();
        bf16_t* d = dst + (size_t)batch * dbs + (size_t)(perm ? up_perm(nt * 64) : nt * 64) * K + kt * 256;
#pragma unroll
        for (int i = 0; i < 4; ++i) {
            const int idx = tid + 512 * i, k8 = (idx >> 10) * 16 + (idx & 15), n = (idx >> 4) & 63;
            const float* l = lf + (k8 * 8) * 65 + n;
            u32x4 w; w.x = pk(l[0], l[65]); w.y = pk(l[130], l[195]); w.z = pk(l[260], l[325]); w.w = pk(l[390], l[455]);
            *(u32x4*)(d + (size_t)n * K + k8 * 8) = w;
        }
        __syncthreads();
    }
    tile0 += ntile;
}

__device__ __forceinline__ void prep_phase(const Params& p, unsigned char* shm) {
    unsigned char* ws = p.ws; float* lf = (float*)shm;
    const int tid = otid(), lane = tid & 63, wid = tid >> 6, G = gridDim.x;
    int t0 = 0;
    tjob(p.in[I_WINA], p.in[I_GMIX], (bf16_t*)(ws + WS_WINA), D, NA, 1, 0, 0, t0, lf);
    tjob(p.in[I_WINB], p.in[I_GMIX] + D, (bf16_t*)(ws + WS_WINB), D, NB, 1, 0, 0, t0, lf);
    tjob(p.in[I_WOUT], nullptr, (bf16_t*)(ws + WS_WOUT), DMIX, D, 2, (size_t)DMIX * D, (size_t)DMIX * D, t0, lf);
    tjob(p.in[I_WUP], p.in[I_GFFN], (bf16_t*)(ws + WS_WUP), D, DFF2, 1, 0, 0, t0, lf, true);
    tjob(p.in[I_WUP] + (size_t)D * DFF2, p.in[I_GFFN] + D, (bf16_t*)(ws + WS_WUP) + (size_t)D * DFF2, D, DFF2, 1, 0, 0, t0, lf, true);
    tjob(p.in[I_WDOWN], nullptr, (bf16_t*)(ws + WS_WDOWN), DFF, D, 2, (size_t)DFF * D, (size_t)DFF * D, t0, lf);
    tjob(p.in[I_WMK], p.in[I_GMEM], (bf16_t*)(ws + WS_WMEM), D, 1024, 1, 0, 0, t0, lf);
    tjob(p.in[I_WMV], p.in[I_GMEM], (bf16_t*)(ws + WS_WMEM) + (size_t)1024 * D, D, 1024, 1, 0, 0, t0, lf);
    tjob(p.in[I_WMK] + (size_t)D * 1024, p.in[I_GMEM] + D, (bf16_t*)(ws + WS_WMEM) + (size_t)2048 * D, D, 1024, 1, 0, 0, t0, lf);
    tjob(p.in[I_WMV] + (size_t)D * 1024, p.in[I_GMEM] + D, (bf16_t*)(ws + WS_WMEM) + (size_t)3072 * D, D, 1024, 1, 0, 0, t0, lf);
    tjob(p.in[I_CMV], nullptr, (bf16_t*)(ws + WS_VT), 256, 1024, 8, (size_t)262144, (size_t)262144, t0, lf);
    tjob(p.in[I_CMV] + (size_t)8 * 262144, nullptr, (bf16_t*)(ws + WS_VT) + (size_t)10 * 262144, 256, 1024, 8, (size_t)262144, (size_t)262144, t0, lf);
    {
        bf16_t* xb = (bf16_t*)(ws + WS_XB); bf16_t* memb = (bf16_t*)(ws + WS_MEMB); float* ss = (float*)(ws + WS_SS); float* ssm = (float*)(ws + WS_SSM);
        for (int row = blockIdx.x * 8 + wid; row < NROWS + 512; row += G * 8) {
            const float* src; bf16_t* db; float* sp;
            if (row < NPROMPT) { src = p.in[I_XP] + (size_t)row * D; db = xb + (size_t)row * D; sp = ss + (size_t)row * 32; }
            else if (row < NROWS) { src = p.in[I_XS] + (size_t)(row - NPROMPT) * D; db = xb + (size_t)row * D; sp = ss + (size_t)row * 32; }
            else { src = p.in[I_MEM] + (size_t)(row - NROWS) * D; db = memb + (size_t)(row - NROWS) * D; sp = ssm + (size_t)(row - NROWS) * 32; }
            float sq = 0.f;
#pragma unroll
            for (int i = 0; i < 8; ++i) {
                const f32x4 v = *(const f32x4*)(src + (i * 64 + lane) * 4);
                sq += (v[0] * v[0] + v[1] * v[1]) + (v[2] * v[2] + v[3] * v[3]);
                u32x2 w; w.x = pk(v[0], v[1]); w.y = pk(v[2], v[3]);
                *(u32x2*)(db + (i * 64 + lane) * 4) = w;
            }
#pragma unroll
            for (int o = 32; o >= 1; o >>= 1) sq += __shfl_xor(sq, o);
            if (lane < 32) sp[lane] = lane == 0 ? sq : 0.f;
        }
    }
    {
        bf16_t* Kb = (bf16_t*)(ws + WS_KB);
        const size_t n4 = (size_t)2 * 8 * 262144 / 4;
        for (size_t i = (size_t)blockIdx.x * 512 + tid; i < n4; i += (size_t)G * 512) {
            const f32x4 v = *(const f32x4*)(p.in[I_CMK] + i * 4);
            const size_t e = i * 4, lb = e / 262144, r = e % 262144, layer = lb / 8, b = lb % 8;
            u32x2 w; w.x = pk(v[0], v[1]); w.y = pk(v[2], v[3]);
            *(u32x2*)(Kb + (layer * 10 + b) * 262144 + r) = w;
        }
        bf16_t* Wm = (bf16_t*)(ws + WS_WM);
        for (int i = blockIdx.x * 512 + tid; i < 8 * 128 * 128; i += G * 512) {
            const int s = i & 127, t = (i >> 7) & 127;
            const float v = s <= t ? p.in[I_GWS][i] : 0.f;
            Wm[i] = (bf16_t)(pk(v, 0.f) & 0xffffu);
        }
    }
}

__device__ __forceinline__ void mixa_rows(const Params& p, const bf16_t* proj, bf16_t* ycat, int rows0, int r0, int r1, int seq0, int seq1, const float* prev, float* state_out, int ch0) {
    const float* cw = p.in[I_CAW];
    float w0[8], w1[8], w2[8], zm2[8], zm1[8];
#pragma unroll
    for (int i = 0; i < 8; ++i) { w0[i] = cw[ch0 + i]; w1[i] = cw[D + ch0 + i]; w2[i] = cw[2 * D + ch0 + i]; }
    {
        const int ra = r0 - 2, rb = r0 - 1;
        if (ra >= seq0) { const bf16_t* q = proj + (size_t)lrow(ra, rows0) * NA; float c[8], h[8]; unpack8(*(const u32x4*)(q + D + ch0), c); unpack8(*(const u32x4*)(q + 2 * D + ch0), h);
#pragma unroll
            for (int i = 0; i < 8; ++i) zm2[i] = c[i] * h[i]; }
        else {
#pragma unroll
            for (int i = 0; i < 8; ++i) zm2[i] = prev ? prev[(ra - seq0 + 2) * D + ch0 + i] : 0.f; }
        if (rb >= seq0) { const bf16_t* q = proj + (size_t)lrow(rb, rows0) * NA; float c[8], h[8]; unpack8(*(const u32x4*)(q + D + ch0), c); unpack8(*(const u32x4*)(q + 2 * D + ch0), h);
#pragma unroll
            for (int i = 0; i < 8; ++i) zm1[i] = c[i] * h[i]; }
        else {
#pragma unroll
            for (int i = 0; i < 8; ++i) zm1[i] = prev ? prev[(rb - seq0 + 2) * D + ch0 + i] : 0.f; }
    }
    int r = r0;
    for (; r + 4 <= r1; r += 4) {
        u32x4 vb[4], vc[4], vh[4];
#pragma unroll
        for (int k = 0; k < 4; ++k) { const bf16_t* q = proj + (size_t)lrow(r + k, rows0) * NA; vb[k] = *(const u32x4*)(q + ch0); vc[k] = *(const u32x4*)(q + D + ch0); vh[k] = *(const u32x4*)(q + 2 * D + ch0); }
#pragma unroll
        for (int k = 0; k < 4; ++k) {
            float b[8], c[8], h[8], y[8], z[8];
            unpack8(vb[k], b); unpack8(vc[k], c); unpack8(vh[k], h);
#pragma unroll
            for (int i = 0; i < 8; ++i) { z[i] = c[i] * h[i]; y[i] = b[i] * (w0[i] * zm2[i] + w1[i] * zm1[i] + w2[i] * z[i]); zm2[i] = zm1[i]; zm1[i] = z[i]; }
            *(u32x4*)(ycat + (size_t)(r + k) * DMIX + ch0) = pack8(y);
            if (r + k >= seq1 - 2) { float* so = state_out + (size_t)(r + k - (seq1 - 2)) * D + ch0; *(f32x4*)so = (f32x4){z[0], z[1], z[2], z[3]}; *(f32x4*)(so + 4) = (f32x4){z[4], z[5], z[6], z[7]}; }
        }
    }
    for (; r < r1; ++r) {
        const bf16_t* q = proj + (size_t)lrow(r, rows0) * NA;
        float b[8], c[8], h[8], y[8], z[8];
        unpack8(*(const u32x4*)(q + ch0), b); unpack8(*(const u32x4*)(q + D + ch0), c); unpack8(*(const u32x4*)(q + 2 * D + ch0), h);
#pragma unroll
        for (int i = 0; i < 8; ++i) { z[i] = c[i] * h[i]; y[i] = b[i] * (w0[i] * zm2[i] + w1[i] * zm1[i] + w2[i] * z[i]); zm2[i] = zm1[i]; zm1[i] = z[i]; }
        *(u32x4*)(ycat + (size_t)r * DMIX + ch0) = pack8(y);
        if (r >= seq1 - 2) { float* so = state_out + (size_t)(r - (seq1 - 2)) * D + ch0; *(f32x4*)so = (f32x4){z[0], z[1], z[2], z[3]}; *(f32x4*)(so + 4) = (f32x4){z[4], z[5], z[6], z[7]}; }
    }
}
__device__ __forceinline__ void mixa_phase(const Params& p, const bf16_t* proj, bf16_t* ycat, int chunk, bool has_s) {
    const int lane = otid() & 63, wid = otid() >> 6, half = wid >> 2, ch0 = (wid & 3) * 512 + lane * 8, rows0 = chunk * CH;
    for (int it = blockIdx.x; it < CH / 64; it += gridDim.x) {
        const int r0 = rows0 + it * 64 + half * 32;
        mixa_rows(p, proj, ycat, rows0, r0, r0 + 32, rows0, rows0 + CH, nullptr, p.out + O_CAP + (size_t)chunk * 2 * D, ch0);
    }
    if (has_s && half == 0)
        for (int it = blockIdx.x; it < NSAMP; it += gridDim.x) {
            const int b = it >> 5, row = NPROMPT + it, s0 = NPROMPT + b * 32;
            mixa_rows(p, proj, ycat, rows0, row, row + 1, s0, s0 + 32, p.in[I_CCA] + (size_t)b * 2 * D, p.out + O_CAS + (size_t)b * 2 * D, ch0);
        }
}

template <bool ISK> __device__ __forceinline__ void attn_fill(unsigned char* shm, const bf16_t* src, int gpitch) {
    const int tid = otid();
    u32x4 v[16];
#pragma unroll
    for (int i = 0; i < 16; ++i) { const int idx = tid + 512 * i, r = idx >> 5, c = idx & 31; v[i] = *(const u32x4*)(src + (size_t)r * gpitch + c * 8); }
#pragma unroll
    for (int i = 0; i < 16; ++i) { const int idx = tid + 512 * i, r = idx >> 5, c = idx & 31; const int f = ISK ? ((r & 3) | (((r >> 3) & 3) << 2)) : (r & 15);
        *(u32x4*)(shm + r * 512 + ((c ^ f) << 4)) = v[i]; }
}
__device__ __forceinline__ void attn_block(const bf16_t* qb, int ldp, const bf16_t* Kg, const bf16_t* Vg, bf16_t* ob, int ngroups, unsigned char* shm) {
    const int tid = otid(), lane = tid & 63, wid = tid >> 6, fr = lane & 15, fq = lane >> 4;
    int offs[4];
#pragma unroll
    for (int b2 = 0; b2 < 4; ++b2) offs[b2] = ((b2 ^ (fr >> 2)) << 6) + ((fq ^ (fr & 3)) << 4);
    const int rbk = (8 * (fr >> 2) + (fr & 3)) * 512, rbv = fr * 512;
    __syncthreads();
    attn_fill<true>(shm, Kg, 1024);
    __syncthreads();
    bf16x8 pf[2][8]; float inv[2];
#pragma unroll
    for (int gi = 0; gi < 2; ++gi) {
        const int grp = wid + 8 * gi;
        if (grp < ngroups) {
            const bf16_t* qg = qb + (size_t)(grp * 16 + fr) * ldp + fq * 8;
            bf16x8 q[8];
#pragma unroll
            for (int ks = 0; ks < 8; ++ks) q[ks] = *(const bf16x8*)(qg + ks * 32);
            f32x4 s[16];
#pragma unroll
            for (int nt = 0; nt < 16; ++nt) {
                f32x4 a = (f32x4){0.f, 0.f, 0.f, 0.f};
#pragma unroll
                for (int ks = 0; ks < 8; ++ks) { const bf16x8 kf = *(const bf16x8*)(shm + (nt >> 1) * 16384 + (nt & 1) * 2048 + rbk + (ks >> 2) * 256 + offs[ks & 3]); a = __builtin_amdgcn_mfma_f32_16x16x32_bf16(kf, q[ks], a, 0, 0, 0); }
                s[nt] = a;
            }
            float mx = -3.0e38f;
#pragma unroll
            for (int nt = 0; nt < 16; ++nt) mx = fmaxf(fmaxf(fmaxf(s[nt][0], s[nt][1]), fmaxf(s[nt][2], s[nt][3])), mx);
            mx = fmaxf(mx, __shfl_xor(mx, 16)); mx = fmaxf(mx, __shfl_xor(mx, 32));
            const float sc = 0.0625f * 1.44269504089f; float sum = 0.f;
#pragma unroll
            for (int nt = 0; nt < 16; ++nt)
#pragma unroll
                for (int j = 0; j < 4; ++j) { const float e = __builtin_amdgcn_exp2f((s[nt][j] - mx) * sc); s[nt][j] = e; sum += e; }
            sum += __shfl_xor(sum, 16); sum += __shfl_xor(sum, 32);
            inv[gi] = 1.0f / sum;
#pragma unroll
            for (int ks = 0; ks < 8; ++ks) { u32x4 w; w.x = pk(s[2 * ks][0], s[2 * ks][1]); w.y = pk(s[2 * ks][2], s[2 * ks][3]); w.z = pk(s[2 * ks + 1][0], s[2 * ks + 1][1]); w.w = pk(s[2 * ks + 1][2], s[2 * ks + 1][3]); pf[gi][ks] = __builtin_bit_cast(bf16x8, w); }
        }
    }
    __syncthreads();
    attn_fill<false>(shm, Vg, 256);
    __syncthreads();
#pragma unroll
    for (int gi = 0; gi < 2; ++gi) {
        const int grp = wid + 8 * gi;
        if (grp < ngroups) {
            bf16_t* og = ob + (size_t)(grp * 16 + fr) * DMIX + 4 * fq;
#pragma unroll
            for (int dt = 0; dt < 16; ++dt) {
                f32x4 o = (f32x4){0.f, 0.f, 0.f, 0.f};
#pragma unroll
                for (int ks = 0; ks < 8; ++ks) { const bf16x8 vf = *(const bf16x8*)(shm + dt * 8192 + rbv + (ks >> 2) * 256 + offs[ks & 3]); o = __builtin_amdgcn_mfma_f32_16x16x32_bf16(vf, pf[gi][ks], o, 0, 0, 0); }
                u32x2 w; w.x = pk(o[0] * inv[gi], o[1] * inv[gi]); w.y = pk(o[2] * inv[gi], o[3] * inv[gi]);
                *(u32x2*)(og + dt * 16) = w;
            }
        }
    }
}
__device__ __forceinline__ void attn_phase(const Params& p, int layer, int chunk, bool has_s, const bf16_t* proj, int ldp, bf16_t* ycat, unsigned char* shm) {
    const int rows0 = chunk * CH;
    const bf16_t* Kb = (const bf16_t*)(p.ws + WS_KB); const bf16_t* Vt = (const bf16_t*)(p.ws + WS_VT);
    const int np = (CH / 256) * 4, nit = np + (has_s ? 32 : 0);
    for (int it = blockIdx.x; it < nit; it += gridDim.x) {
        int hd, t0, bb, ng;
        if (it < np) { hd = it & 3; t0 = rows0 + (it >> 2) * 256; bb = 8 + chunk; ng = 16; }
        else { const int i2 = it - np; hd = i2 & 3; bb = i2 >> 2; t0 = NPROMPT + bb * 32; ng = 2; }
        const int bbi = layer * 10 + bb; const size_t lr = (size_t)lrow(t0, rows0);
        attn_block(proj + lr * ldp + (ldp - 1024) + hd * 256, ldp, Kb + (size_t)bbi * 262144 + hd * 256, Vt + ((size_t)bbi * 4 + hd) * 65536, ycat + (size_t)t0 * DMIX + D + hd * 256, ng, shm);
    }
    __syncthreads();
}

__device__ __forceinline__ void stats_phase(const Params& p, const bf16_t* proj, int chunk, bool has_s) {
    const int lane = otid() & 63, wid = otid() >> 6, rows0 = chunk * CH;
    float* stats = (float*)(p.ws + WS_STATS);
    const int nr = CH + (has_s ? NSAMP : 0);
    for (int i = blockIdx.x * 8 + wid; i < nr; i += gridDim.x * 8) {
        const int row = i < CH ? rows0 + i : NPROMPT + (i - CH);
        const bf16_t* q = proj + (size_t)lrow(row, rows0) * NB + D;
        float v[32]; float s = 0.f;
#pragma unroll
        for (int k = 0; k < 4; ++k) { float f[8]; unpack8(*(const u32x4*)(q + (k * 64 + lane) * 8), f);
#pragma unroll
            for (int j = 0; j < 8; ++j) { v[k * 8 + j] = f[j]; s += f[j]; } }
#pragma unroll
        for (int o = 32; o >= 1; o >>= 1) s += __shfl_xor(s, o);
        const float mean = s * (1.0f / 2048.0f); float qq = 0.f;
#pragma unroll
        for (int j = 0; j < 32; ++j) { const float d = v[j] - mean; qq += d * d; }
#pragma unroll
        for (int o = 32; o >= 1; o >>= 1) qq += __shfl_xor(qq, o);
        if (lane == 0) { stats[(size_t)row * 2] = mean; stats[(size_t)row * 2 + 1] = rsqrtf(qq * (1.0f / 2048.0f) + EPS); }
    }
}
constexpr int VS = 136;
__device__ __forceinline__ void gmlp_item(const Params& p, const bf16_t* proj, bf16_t* ycat, int rows0, int row0, int nrows, int g, int sb, unsigned char* shm) {
    const int tid = otid(), lane = tid & 63, wid = tid >> 6, fr = lane & 15, fq = lane >> 4;
    bf16_t* vT = (bf16_t*)shm;
    const float* stats = (const float*)(p.ws + WS_STATS);
    {
        const int d0 = (tid & 31) * 8, c0 = g * 256 + d0;
        float gam[8], bet[8];
#pragma unroll
        for (int j = 0; j < 8; ++j) { gam[j] = p.in[I_GNG][c0 + j]; bet[j] = p.in[I_GNB][c0 + j]; }
#pragma unroll 2
        for (int i = 0; i < 8; ++i) {
            const int s = (tid >> 5) + 16 * i;
            float vn[8];
            if (s < nrows) {
                const int r = row0 + s;
                float f[8]; unpack8(*(const u32x4*)(proj + (size_t)lrow(r, rows0) * NB + D + c0), f);
                const float mean = stats[(size_t)r * 2], rstd = stats[(size_t)r * 2 + 1];
#pragma unroll
                for (int j = 0; j < 8; ++j) vn[j] = (f[j] - mean) * rstd * gam[j] + bet[j];
                if (sb >= 0) { float* o = p.out + O_GVS + ((size_t)(sb * 32 + s)) * D + c0; *(f32x4*)o = (f32x4){vn[0], vn[1], vn[2], vn[3]}; *(f32x4*)(o + 4) = (f32x4){vn[4], vn[5], vn[6], vn[7]}; }
            } else {
#pragma unroll
                for (int j = 0; j < 8; ++j) vn[j] = 0.f;
            }
#pragma unroll
            for (int j = 0; j < 4; ++j) { const unsigned w = pk(vn[2 * j], vn[2 * j + 1]); const int sx = s ^ (((tid & 31) & 15) << 3);
                vT[(d0 + 2 * j) * VS + sx] = (bf16_t)(w & 0xffffu); vT[(d0 + 2 * j + 1) * VS + sx] = (bf16_t)(w >> 16); }
        }
    }
    __syncthreads();
    const bf16_t* Wm = (const bf16_t*)(p.ws + WS_WM) + (size_t)g * 16384;
    const int ntt = nrows >> 4, dbase = wid * 32;
    f32x4 acc[2][8];
#pragma unroll
    for (int dt = 0; dt < 2; ++dt)
#pragma unroll
        for (int tt = 0; tt < 8; ++tt) acc[dt][tt] = (f32x4){0.f, 0.f, 0.f, 0.f};
#pragma unroll
    for (int ks = 0; ks < 4; ++ks) {
        if (ks * 32 < nrows) {
            bf16x8 af[2];
#pragma unroll
            for (int dt = 0; dt < 2; ++dt) { const int d = dbase + dt * 16 + fr; af[dt] = *(const bf16x8*)(vT + d * VS + ((ks * 32 + fq * 8) ^ (((d >> 3) & 15) << 3))); }
#pragma unroll
            for (int tt = 0; tt < 8; ++tt) {
                if (tt < ntt && ks * 32 <= tt * 16 + 15) {
                    const bf16x8 bw = *(const bf16x8*)(Wm + (size_t)(tt * 16 + fr) * 128 + ks * 32 + fq * 8);
#pragma unroll
                    for (int dt = 0; dt < 2; ++dt) acc[dt][tt] = __builtin_amdgcn_mfma_f32_16x16x32_bf16(af[dt], bw, acc[dt][tt], 0, 0, 0);
                }
            }
        }
    }
    const float* gb = p.in[I_GBIAS] + g * 128;
#pragma unroll
    for (int tt = 0; tt < 8; ++tt) {
        if (tt < ntt) {
            const int t = tt * 16 + fr; const size_t lr = (size_t)lrow(row0 + t, rows0);
            const float bias = gb[t];
#pragma unroll
            for (int dt = 0; dt < 2; ++dt) {
                const int dc = g * 256 + dbase + dt * 16 + 4 * fq;
                const u32x2 uu = *(const u32x2*)(proj + lr * NB + dc);
                const f32x4 a = acc[dt][tt];
                u32x2 w; w.x = pk(bf_lo(uu.x) * (a[0] + bias), bf_hi(uu.x) * (a[1] + bias)); w.y = pk(bf_lo(uu.y) * (a[2] + bias), bf_hi(uu.y) * (a[3] + bias));
                *(u32x2*)(ycat + (size_t)(row0 + t) * DMIX + dc) = w;
            }
        }
    }
    __syncthreads();
}
__device__ __forceinline__ void gmlp_phase(const Params& p, const bf16_t* proj, bf16_t* ycat, int chunk, bool has_s, unsigned char* shm) {
    const int rows0 = chunk * CH;
    const int nit = (CH / 128) * 8 + (has_s ? 64 : 0);
    for (int it = blockIdx.x; it < nit; it += gridDim.x) {
        if (it < (CH / 128) * 8) gmlp_item(p, proj, ycat, rows0, rows0 + (it >> 3) * 128, 128, it & 7, -1, shm);
        else { const int i2 = it - (CH / 128) * 8, b = i2 >> 3; gmlp_item(p, proj, ycat, rows0, NPROMPT + b * 32, 32, i2 & 7, b, shm); }
    }
}

__device__ __forceinline__ void ffn_rows(const Params& p, int layer, const bf16_t* z, bf16_t* h, int rows0, int r0, int r1, int seq0, int seq1, const float* prev, float* state_out, int c0) {
    const float* cw = p.in[I_FCW] + (size_t)layer * 3 * DFF2; const float* cb = p.in[I_FCB] + (size_t)layer * DFF2;
    float wa[3][8], wg[3][8], ba[8], bg[8], am2[8], am1[8], gm2[8], gm1[8];
    const int za_off = (c0 >> 7) * 256 + (c0 & 127), zg_off = za_off + 128;
#pragma unroll
    for (int k = 0; k < 3; ++k)
#pragma unroll
        for (int i = 0; i < 8; ++i) { wa[k][i] = cw[k * DFF2 + c0 + i]; wg[k][i] = cw[k * DFF2 + DFF + c0 + i]; }
#pragma unroll
    for (int i = 0; i < 8; ++i) { ba[i] = cb[c0 + i]; bg[i] = cb[DFF + c0 + i]; }
    {
        const int ra = r0 - 2, rb = r0 - 1;
        if (ra >= seq0) { const bf16_t* q = z + (size_t)lrow(ra, rows0) * DFF2; unpack8(*(const u32x4*)(q + za_off), am2); unpack8(*(const u32x4*)(q + zg_off), gm2); }
        else {
#pragma unroll
            for (int i = 0; i < 8; ++i) { am2[i] = prev ? prev[(size_t)(ra - seq0 + 2) * DFF2 + c0 + i] : 0.f; gm2[i] = prev ? prev[(size_t)(ra - seq0 + 2) * DFF2 + DFF + c0 + i] : 0.f; } }
        if (rb >= seq0) { const bf16_t* q = z + (size_t)lrow(rb, rows0) * DFF2; unpack8(*(const u32x4*)(q + za_off), am1); unpack8(*(const u32x4*)(q + zg_off), gm1); }
        else {
#pragma unroll
            for (int i = 0; i < 8; ++i) { am1[i] = prev ? prev[(size_t)(rb - seq0 + 2) * DFF2 + c0 + i] : 0.f; gm1[i] = prev ? prev[(size_t)(rb - seq0 + 2) * DFF2 + DFF + c0 + i] : 0.f; } }
    }
#pragma unroll 4
    for (int r = r0; r < r1; ++r) {
        const bf16_t* q = z + (size_t)lrow(r, rows0) * DFF2;
        float a[8], g[8], o[8];
        unpack8(*(const u32x4*)(q + za_off), a); unpack8(*(const u32x4*)(q + zg_off), g);
#pragma unroll
        for (int i = 0; i < 8; ++i) {
            const float ca = wa[0][i] * am2[i] + wa[1][i] * am1[i] + wa[2][i] * a[i] + ba[i];
            const float cg = wg[0][i] * gm2[i] + wg[1][i] * gm1[i] + wg[2][i] * g[i] + bg[i];
            o[i] = ca * cg * __builtin_amdgcn_rcpf(1.0f + __builtin_amdgcn_exp2f(-1.44269504089f * cg));
            am2[i] = am1[i]; am1[i] = a[i]; gm2[i] = gm1[i]; gm1[i] = g[i];
        }
        *(u32x4*)(h + (size_t)r * DFF + c0) = pack8(o);
        if (r >= seq1 - 2) { float* so = state_out + (size_t)(r - (seq1 - 2)) * DFF2 + c0;
            *(f32x4*)so = (f32x4){a[0], a[1], a[2], a[3]}; *(f32x4*)(so + 4) = (f32x4){a[4], a[5], a[6], a[7]};
            *(f32x4*)(so + DFF) = (f32x4){g[0], g[1], g[2], g[3]}; *(f32x4*)(so + DFF + 4) = (f32x4){g[4], g[5], g[6], g[7]}; }
    }
}
__device__ __forceinline__ void ffn_mid_phase(const Params& p, int layer, const bf16_t* z, bf16_t* h, int chunk, bool has_s) {
    const int tid = otid(), lane = tid & 63, wid = tid >> 6, rows0 = chunk * CH;
    if (!has_s) return;
    const int nw = gridDim.x * 8;
    for (int i2 = nw - 1 - (int)(blockIdx.x * 8 + wid); i2 < 8 * 8 * 11; i2 += nw) {
        const int cbk = i2 % 11, rb = i2 / 11, b = rb >> 3, s0 = NPROMPT + b * 32, r0 = s0 + (rb & 7) * 4;
        ffn_rows(p, layer, z, h, rows0, r0, r0 + 4, s0, s0 + 32, p.in[I_CFC] + (size_t)((layer * 8 + b) * 2) * DFF2, p.out + O_FCS + (size_t)((layer * 8 + b) * 2) * DFF2, (cbk * 64 + lane) * 8);
    }
}
__device__ __forceinline__ void ffn_fix_phase(const Params& p, int layer, const float* halo, bf16_t* h) {
    const int tid = otid(), lane = tid & 63, wid = tid >> 6;
    const float* cw = p.in[I_FCW] + (size_t)layer * 3 * DFF2; const float* cb = p.in[I_FCB] + (size_t)layer * DFF2;
    for (int it = blockIdx.x * 8 + wid; it < (NPROMPT / 64) * 11; it += gridDim.x * 8) {
        const int blk = it / 11, c0 = ((it % 11) * 64 + lane) * 8, bseq = blk & (CH / 64 - 1), chunk = blk / (CH / 64);
        float o0[8], o1[8];
#pragma unroll
        for (int part = 0; part < 2; ++part) {
            const int cc = part * DFF + c0;
            float w0[8], w1[8], w2[8], bb[8], z0[8], z1[8], zm1[8], zm2[8];
#pragma unroll
            for (int i = 0; i < 8; ++i) { w0[i] = cw[cc + i]; w1[i] = cw[DFF2 + cc + i]; w2[i] = cw[2 * DFF2 + cc + i]; bb[i] = cb[cc + i]; }
            const float* hp = halo + (size_t)blk * 4 * DFF2 + cc;
#pragma unroll
            for (int i = 0; i < 8; ++i) { z0[i] = hp[i]; z1[i] = hp[DFF2 + i]; zm2[i] = bseq > 0 ? hp[i - 2 * DFF2] : 0.f; zm1[i] = bseq > 0 ? hp[i - DFF2] : 0.f; }
#pragma unroll
            for (int i = 0; i < 8; ++i) {
                const float c_0 = w0[i] * zm2[i] + w1[i] * zm1[i] + w2[i] * z0[i] + bb[i];
                const float c_1 = w0[i] * zm1[i] + w1[i] * z0[i] + w2[i] * z1[i] + bb[i];
                if (part == 0) { o0[i] = c_0; o1[i] = c_1; }
                else { o0[i] = o0[i] * c_0 * __builtin_amdgcn_rcpf(1.0f + __builtin_amdgcn_exp2f(-1.44269504089f * c_0)); o1[i] = o1[i] * c_1 * __builtin_amdgcn_rcpf(1.0f + __builtin_amdgcn_exp2f(-1.44269504089f * c_1)); }
            }
            if (bseq == CH / 64 - 1) {
                float* so = p.out + O_FCP + (size_t)((layer * 2 + chunk) * 2) * DFF2 + cc;
#pragma unroll
                for (int i = 0; i < 8; ++i) { so[i] = hp[2 * DFF2 + i]; so[DFF2 + i] = hp[3 * DFF2 + i]; }
            }
        }
        *(u32x4*)(h + (size_t)(blk * 64) * DFF + c0) = pack8(o0);
        *(u32x4*)(h + (size_t)(blk * 64 + 1) * DFF + c0) = pack8(o1);
    }
}

__device__ __forceinline__ void final_phase(const Params& p) {
    const int tid = otid(), lane = tid & 63, wid = tid >> 6;
    const float* ss = (const float*)(p.ws + WS_SS); const float* gf = p.in[I_GFIN]; const bf16_t* xb = (const bf16_t*)(p.ws + WS_XB);
    for (int row = blockIdx.x * 8 + wid; row < NROWS; row += gridDim.x * 8) {
        float s = lane < 32 ? ss[(size_t)row * 32 + lane] : 0.f;
#pragma unroll
        for (int o = 32; o >= 1; o >>= 1) s += __shfl_xor(s, o);
        const float rs = rsqrtf(s * (1.0f / 2048.0f) + EPS);
        const bf16_t* x = xb + (size_t)row * D; float* y = p.out + (size_t)row * D;
#pragma unroll
        for (int k = 0; k < 4; ++k) { const int c = (k * 64 + lane) * 8; float f[8]; unpack8(*(const u32x4*)(x + c), f);
            const f32x4 g0 = *(const f32x4*)(gf + c), g1 = *(const f32x4*)(gf + c + 4);
            *(f32x4*)(y + c) = (f32x4){f[0], f[1], f[2], f[3]} * rs * g0; *(f32x4*)(y + c + 4) = (f32x4){f[4], f[5], f[6], f[7]} * rs * g1; }
    }
}

__global__ void __launch_bounds__(512, 2) fwd_kernel(Params p) {
    extern __shared__ __attribute__((aligned(16))) unsigned char shm[];
    cg::grid_group grid = cg::this_grid();
    LAS unsigned char* lds0 = (LAS unsigned char*)shm;
    {
        volatile LAS unsigned* st = (volatile LAS unsigned*)(lds0 + pg8::STAGE_BYTES);
        if (threadIdx.x < 2) st[threadIdx.x] = 0u;
        __syncthreads();
    }
    const XcdBarrier xbar = xcd_barrier_post((unsigned*)(p.ws + WS_BAR), (volatile LAS unsigned*)(lds0 + pg8::STAGE_BYTES));
#define GSYNC() do { for (int rep_ = 0; rep_ < REP_SYNC; ++rep_) xcd_barrier(xbar); } while (0)
    PG8_LAS unsigned char* lds = (PG8_LAS unsigned char*)shm;
    unsigned char* ws = p.ws;
    const int G = gridDim.x, bid = blockIdx.x;
    bf16_t* xb = (bf16_t*)(ws + WS_XB); float* ss = (float*)(ws + WS_SS);
    bf16_t* proj = (bf16_t*)(ws + WS_BIG + BIG_PROJ); bf16_t* ycat = (bf16_t*)(ws + WS_BIG + BIG_YCAT);
    bf16_t* hb = (bf16_t*)(ws + WS_BIG + BIG_H); float* halo = (float*)(ws + WS_BIG + BIG_HALO);
    bf16_t* zb = (bf16_t*)(ws + WS_BIG + BIG_ZS) - (size_t)CH * DFF2;

    for (int rep = 0; rep < REP_PREP; ++rep) prep_phase(p, shm);
    if (p.ws == nullptr) grid.sync();
    GSYNC();

#pragma unroll 1
    for (int layer = 0; layer < 2; ++layer) {
#pragma unroll 1
        for (int chunk = 0; chunk < 2; ++chunk) {
            const int rows0 = chunk * CH; const bool has_s = chunk == 0;
            {
                const int N1 = layer ? NB : NA; const bf16_t* W1 = (const bf16_t*)(ws + (layer ? WS_WINB : WS_WINA));
                const OpScale op{ss, proj, N1, rows0, layer ? 2 * D : 0};
                pg8::Gemm g{xb + (size_t)rows0 * D, W1, CH, N1, D}; pg8::StaticOrder S; S.init(CH, N1, G, bid);
                EpiG<OpScale> E{op, rows0};
                pg8::gemm_phase<EpiG<OpScale>, pg8::StaticOrder, GEMM_ALIGN, GEMM_SP2>(lds, g, S, E);
                if (has_s) small_gemm(xb + (size_t)NPROMPT * D, D, W1, NSAMP, N1, D, op, NPROMPT, shm);
                if (chunk == 0 && layer == 0) {
                    const OpMemKV om{(const float*)(ws + WS_SSM), p.out + O_MKP, p.out + O_MVP, (bf16_t*)(ws + WS_KB), (bf16_t*)(ws + WS_VT)};
                    small_gemm((const bf16_t*)(ws + WS_MEMB), D, (const bf16_t*)(ws + WS_WMEM), 512, 4096, D, om, 0, shm);
                }
            }
            GSYNC();
            if (layer == 0) {
                mixa_phase(p, proj, ycat, chunk, has_s);
                attn_phase(p, 0, chunk, has_s, proj, NA, ycat, shm);
            }
            else {
                stats_phase(p, proj, chunk, has_s);
                GSYNC();
                gmlp_phase(p, proj, ycat, chunk, has_s, shm);
                attn_phase(p, 1, chunk, has_s, proj, NB, ycat, shm);
            }
            GSYNC();
        }
        {
            const bf16_t* W = (const bf16_t*)(ws + WS_WOUT) + (size_t)layer * D * DMIX;
            const OpResid opp{xb, ss};
            const OpResid ops{xb, ss};
            pg8::Gemm g{ycat, W, NPROMPT, D, DMIX}; pg8::StaticOrder S; S.init(NPROMPT, D, G, bid);
            EpiG<OpResid> E{opp, 0};
            pg8::gemm_phase<EpiG<OpResid>, pg8::StaticOrder, GEMM_ALIGN, GEMM_SP2>(lds, g, S, E);
            small_gemm(ycat + (size_t)NPROMPT * DMIX, DMIX, W, NSAMP, D, DMIX, ops, NPROMPT, shm);
        }
        GSYNC();
        {
            const bf16_t* W = (const bf16_t*)(ws + WS_WUP) + (size_t)layer * D * DFF2;
            const OpScale op{ss, zb, DFF2, 0, 0};
            pg8::Gemm g{xb, W, NPROMPT, DFF2, D}; pg8::StaticOrder S; S.init(NPROMPT, DFF2, G, bid);
            const EpiFfn E{ss, p.in[I_FCW] + (size_t)layer * 3 * DFF2, p.in[I_FCB] + (size_t)layer * DFF2, hb, halo, 0};
            pg8::gemm_phase<EpiFfn, pg8::StaticOrder, GEMM_ALIGN, GEMM_SP2>(lds, g, S, E);
            small_gemm(xb + (size_t)NPROMPT * D, D, W, NSAMP, DFF2, D, op, NPROMPT, shm);
        }
        GSYNC();
        ffn_fix_phase(p, layer, halo, hb);
        ffn_mid_phase(p, layer, zb, hb, 0, true);
        GSYNC();
        {
            const bf16_t* W = (const bf16_t*)(ws + WS_WDOWN) + (size_t)layer * D * DFF;
            const OpResid op{xb, ss};
            pg8::Gemm g{hb, W, NPROMPT, D, DFF}; pg8::StaticOrder S; S.init(NPROMPT, D, G, bid);
            EpiG<OpResid> E{op, 0};
            pg8::gemm_phase<EpiG<OpResid>, pg8::StaticOrder, GEMM_ALIGN, GEMM_SP2>(lds, g, S, E);
            small_gemm(hb + (size_t)NPROMPT * DFF, DFF, W, NSAMP, D, DFF, op, NPROMPT, shm);
        }
        GSYNC();
    }
    final_phase(p);
}

extern "C" void kernel_launch(void* const* d_in, const int* in_sizes, int n_in, void* d_out, int out_size, void* d_ws, size_t ws_size, hipStream_t stream) {
    static int grid = 0;
    if (grid == 0) {
        if (n_in != 25 || ws_size < WS_END) { fprintf(stderr, "kernel_launch: unexpected shapes: n_in %d ws %zu (need %zu)\n", n_in, ws_size, (size_t)WS_END); grid = -1; return; }
        int dev = 0, cus = 0, per_cu = 0;
        hipGetDevice(&dev);
        hipDeviceGetAttribute(&cus, hipDeviceAttributeMultiprocessorCount, dev);
        if (hipFuncSetAttribute((const void*)fwd_kernel, hipFuncAttributeMaxDynamicSharedMemorySize, LDS_BYTES) != hipSuccess) { fprintf(stderr, "kernel_launch: hipFuncSetAttribute failed\n"); }
        if (hipOccupancyMaxActiveBlocksPerMultiprocessor(&per_cu, (const void*)fwd_kernel, 512, LDS_BYTES) != hipSuccess || per_cu < 1) { fprintf(stderr, "kernel_launch: occupancy query says %d\n", per_cu); per_cu = 1; }
        (void)hipGetLastError();
        grid = cus;
    }
    if (grid < 0) return;
    if (hipMemsetAsync((char*)d_ws + WS_BAR, 0, 16384, stream) != hipSuccess) { fprintf(stderr, "kernel_launch: memset of the barrier words failed\n"); return; }
    Params p{};
    for (int i = 0; i < 25; ++i) p.in[i] = (const float*)d_in[i];
    p.out = (float*)d_out; p.ws = (unsigned char*)d_ws;
    void* args[] = {&p};
    hipError_t e = hipLaunchCooperativeKernel((const void*)fwd_kernel, dim3(grid), dim3(512), args, LDS_BYTES, stream);
    if (e != hipSuccess) fprintf(stderr, "kernel_launch: cooperative launch failed: %s (grid %d)\n", hipGetErrorString(e), grid);
}
```

```cpp
#include <hip/hip_runtime.h>
#include <hip/hip_cooperative_groups.h>
#include <cstdio>
namespace cg = cooperative_groups;
#define REP_ATTN 1
#define REP_ELEM 1
#define REP_PREP 1
#define REP_GEMM 1
#define REP_SMALL 1
#define REP_SYNC 1
#define GEMM_ALIGN true
#define GEMM_SP2 true
#define STAGGER 1

#define XB_TMO      128
#define XB_XCNT(j)  (256  + 64 * (j))
#define XB_XSUB(j)  (1280 + 64 * (j))
#define XB_XGEN(j)  (2304 + 64 * (j))
#define XB_TOP      3328
#define XB_TOPGEN   3392
#define XCD_BAR_WORDS 3456
#define XB_SPIN_CAP (1u << 18)
#define LAS __attribute__((address_space(3)))

__device__ __forceinline__ unsigned xb_ld(unsigned* p)              { return __hip_atomic_load(p, __ATOMIC_RELAXED, __HIP_MEMORY_SCOPE_AGENT); }
__device__ __forceinline__ unsigned xb_add(unsigned* p, unsigned v) { return __hip_atomic_fetch_add(p, v, __ATOMIC_RELAXED, __HIP_MEMORY_SCOPE_AGENT); }
__device__ __forceinline__ unsigned xb_xcc_id() { return (unsigned)__builtin_amdgcn_s_getreg((3 << 11) | 20) & 0xFu; }
#define XB_SPIN(cond, bar) do { unsigned _sp = 0; while (cond) { __builtin_amdgcn_s_sleep(1); \
    if ((++_sp & 255u) == 0u) { if (xb_ld(&(bar)[XB_TMO])) break; if (_sp > XB_SPIN_CAP) { atomicAdd(&(bar)[XB_TMO], 1u); break; } } } } while (0)

struct XcdBarrier {
    unsigned* bar; unsigned x;
    volatile LAS unsigned* st;
};

__device__ __forceinline__ XcdBarrier xcd_barrier_post(unsigned* bar, volatile LAS unsigned* st) {
    XcdBarrier b; b.bar = bar; b.x = xb_xcc_id(); b.st = st;
    if (threadIdx.x == 0) (void)xb_add(&bar[XB_XCNT(b.x)], 1u);
    return b;
}
__device__ __forceinline__ void xcd_barrier_complete(unsigned* bar, unsigned x, unsigned& nloc, unsigned& nx) {
    const unsigned G = gridDim.x * gridDim.y * gridDim.z;
    unsigned sum, cnt, mine, sp = 0u;
    for (;;) {
        sum = 0u; cnt = 0u; mine = 0u;
#pragma unroll
        for (unsigned j = 0; j < 16; ++j) { const unsigned c = xb_ld(&bar[XB_XCNT(j)]); sum += c; cnt += (c > 0u) ? 1u : 0u; mine = (j == x) ? c : mine; }
        if (sum == G) break;
        __builtin_amdgcn_s_sleep(1);
        if ((++sp & 255u) == 0u) { if (xb_ld(&bar[XB_TMO])) break; if (sp > XB_SPIN_CAP) { atomicAdd(&bar[XB_TMO], 1u); break; } }
    }
    nloc = mine > 0u ? mine : 1u; nx = cnt > 0u ? cnt : 1u;
}

__device__ __forceinline__ void xcd_barrier(const XcdBarrier& b) {
    asm volatile("s_waitcnt vmcnt(0)" ::: "memory");
    __syncthreads();
    if (threadIdx.x == 0) {
        unsigned* bar = b.bar;
        __builtin_amdgcn_s_waitcnt(0);
        unsigned nloc = b.st[0], nx = b.st[1];
        if (nloc == 0u) { xcd_barrier_complete(bar, b.x, nloc, nx); b.st[0] = nloc; b.st[1] = nx; }
        const unsigned old = xb_add(&bar[XB_XSUB(b.x)], 1u);
        const unsigned gen = old / nloc;
        if (old + 1u == (gen + 1u) * nloc) {
            __builtin_amdgcn_fence(__ATOMIC_RELEASE, "agent");
            asm volatile("s_waitcnt vmcnt(0)" ::: "memory");
            const unsigned og = xb_add(&bar[XB_TOP], 1u);
            const unsigned tg = og / nx;
            if (og + 1u == (tg + 1u) * nx) xb_add(&bar[XB_TOPGEN], 1u);
            else XB_SPIN(xb_ld(&bar[XB_TOPGEN]) == tg, bar);
            __builtin_amdgcn_fence(__ATOMIC_ACQUIRE, "agent");
            xb_add(&bar[XB_XGEN(b.x)], 1u);
            asm volatile("s_waitcnt vmcnt(0)" ::: "memory");
        } else {
            XB_SPIN(xb_ld(&bar[XB_XGEN(b.x)]) == gen, bar);
            __builtin_amdgcn_fence(__ATOMIC_ACQUIRE, "agent");
            asm volatile("s_waitcnt vmcnt(0)" ::: "memory");
        }
    }
    __syncthreads();
}
namespace pg8 {
#define PG8_LAS __attribute__((address_space(3)))
typedef unsigned short bf16_t;
}
__device__ __forceinline__ int otid() { int t = threadIdx.x; asm volatile("" : "+v"(t)); return t; }
namespace pg8 {
typedef short bf16x8 __attribute__((ext_vector_type(8)));
typedef float f32x4 __attribute__((ext_vector_type(4)));
typedef unsigned u32x4 __attribute__((ext_vector_type(4)));
constexpr int BM = 256, BK = 64, HALF = 128, HTB = HALF * BK * 2  , STAGE_BYTES = 8 * HTB, NXCD = 8, WGM = 4;

__host__ __device__ __forceinline__ int lds_byte(int r, int c) { const int st = (r >> 4) * 2 + (c >> 5), rr = r & 15, cc = c & 31, ob = rr * 64 + cc * 2; return st * 1024 + (ob ^ (((ob >> 9) & 1) << 5)); }
__host__ __device__ __forceinline__ void stage_rc(int b, int& R, int& C) { const int st = b / 1024, sb = b % 1024, swz = sb ^ (((sb >> 9) & 1) << 5); R = (st >> 1) * 16 + swz / 64; C = (st & 1) * 32 + (swz % 64) / 2; }
__host__ __device__ __forceinline__ int perm32(int rho) { const int n = rho >> 4, i = rho & 15; return 8 * (i >> 2) + 4 * n + (i & 3); }

struct Unit { int pm, pn; };
struct Gemm { const bf16_t* A; const bf16_t* Bt; int M, N, K; };

struct StaticOrder {
    int nM, nN, nwg, G, c;
    __host__ __device__ void init(int M, int N, int G_, int c_) { nM = M / BM; nN = N / BM; nwg = nM * nN; G = G_; c = c_; }
    __host__ __device__ bool next(int i, Unit& u) const {
        const long L = (long)i * G + c; if (L >= nwg) return false;
        int wgid = (int)L; { const int q = nwg / NXCD, r = nwg % NXCD, xcd = wgid % NXCD, off = wgid / NXCD; wgid = (xcd < r ? xcd * (q + 1) : r * (q + 1) + (xcd - r) * q) + off; }
        const int nig = WGM * nN, gid = wgid / nig, fm = gid * WGM, gsz = (nM - fm) < WGM ? (nM - fm) : WGM;
        u.pm = fm + ((wgid % nig) % gsz); u.pn = (wgid % nig) / gsz; return true;
    }
    __device__ __forceinline__ void a_ready(const Unit&) const {}
    __device__ __forceinline__ void done(const Unit&) const {}
};
__device__ __forceinline__ unsigned cvt_pk_bf16(float lo, float hi) { unsigned r; asm volatile("v_cvt_pk_bf16_f32 %0, %1, %2" : "=v"(r) : "v"(lo), "v"(hi)); return r; }
typedef float f32x2 __attribute__((ext_vector_type(2)));
__device__ __forceinline__ f32x2 gelu_pk(f32x2 v) {
    const f32x2 av = __builtin_elementwise_abs(v), d = av * 0.2316418882f + 1.0f;
    f32x2 t; t.x = __builtin_amdgcn_rcpf(d.x); t.y = __builtin_amdgcn_rcpf(d.y);
    f32x2 q = t * 0.5307027145f + (-0.7265760135f); q = q * t + 0.7107068705f; q = q * t + (-0.142248368f); q = q * t + 0.127414796f; q = q * t;
    const f32x2 s = (v * v) * (-0.72134752044f);
    f32x2 e; e.x = __builtin_amdgcn_exp2f(s.x); e.y = __builtin_amdgcn_exp2f(s.y);
    const f32x2 m = v * (q * e), r = v - m;
    f32x2 o; o.x = v.x < 0.f ? m.x : r.x; o.y = v.y < 0.f ? m.y : r.y; return o;
}
template <class Epi, class Sched, bool ALIGN_EPI = false, bool SP2 = false>
__device__ __forceinline__ void gemm_phase(PG8_LAS unsigned char* lds, const Gemm g, const Sched& S, const Epi& E) {
    const int tid = otid(), wid = __builtin_amdgcn_readfirstlane(tid >> 6), lane = tid & 63, wr = wid >> 2, wc = wid & 3, fr = lane & 15, fq = lane >> 4;
    const int K = g.K, nt = K / BK;
    unsigned voffA[2], voffB[2];
#pragma unroll
    for (int i = 0; i < 2; ++i) { int R, C; stage_rc(tid * 16 + i * 8192, R, C); const int Rb = Epi::PERM ? ((R & ~31) + perm32(R & 31)) : R;
        const int Ra = Epi::APERM ? ((R & ~63) + 4 * (R & 15) + ((R >> 4) & 3)) : R;
        voffA[i] = (unsigned)(Ra * K + C) * 2u; voffB[i] = (unsigned)(Rb * K + C) * 2u; }
    const size_t kstep = (size_t)(BK * 2);
    const size_t hstep = (size_t)HALF * K * 2;
    const size_t tstep = 2 * hstep;
    const unsigned ldsw = (unsigned)wid * 1024u;
    const int aoff = lds_byte(wr * 64 + fr, fq * 8), boff = lds_byte(wc * 32 + fr, fq * 8);
#define PG8_SA(b, h) (((b) * 2 + (h)) * HTB)
#define PG8_SB(b, h) ((4 + (b) * 2 + (h)) * HTB)
#define PG8_STAGE(bufoff, gbase, voff) do { _Pragma("unroll") for (int _i = 0; _i < 2; ++_i) \
        __builtin_amdgcn_global_load_lds((const unsigned*)((const char*)(gbase) + (voff)[_i]), (PG8_LAS unsigned*)(lds + (bufoff) + ldsw + _i * 8192), 16, 0, 0); } while (0)
#define PG8_LDA(dst, b, h) do { _Pragma("unroll") for (int m = 0; m < 4; ++m) _Pragma("unroll") for (int k = 0; k < 2; ++k) dst[m][k] = *(const PG8_LAS bf16x8*)(lds + PG8_SA(b, h) + aoff + m * 2048 + k * 1024); } while (0)
#define PG8_LDB(dst, b, h) do { _Pragma("unroll") for (int n = 0; n < 2; ++n) _Pragma("unroll") for (int k = 0; k < 2; ++k) dst[n][k] = *(const PG8_LAS bf16x8*)(lds + PG8_SB(b, h) + boff + n * 2048 + k * 1024); } while (0)
#define PG8_MMA(ai, bj, At, Bt) do { __builtin_amdgcn_s_setprio(1); _Pragma("unroll") for (int m = 0; m < 4; ++m) _Pragma("unroll") for (int n = 0; n < 2; ++n) _Pragma("unroll") for (int k = 0; k < 2; ++k) \
        acc[ai][bj][m][n] = __builtin_amdgcn_mfma_f32_16x16x32_bf16(Bt[n][k], At[m][k], acc[ai][bj][m][n], 0, 0, 0); __builtin_amdgcn_s_setprio(0); } while (0)
#define PG8_WAIT_V(n) asm volatile("s_waitcnt vmcnt(" #n ")" ::: "memory")
#define PG8_WAIT_L(n) asm volatile("s_waitcnt lgkmcnt(" #n ")" ::: "memory")
#define PG8_BAR __builtin_amdgcn_s_barrier()
#define PG8_SCHED __builtin_amdgcn_sched_barrier(0)
    Unit cur, nxt; int ui = 0;
    if (!S.next(0, cur)) return;
    typename Epi::State est; E.init_state(est, cur, lds, tid);
    f32x4 acc[2][2][4][2];
#pragma unroll
    for (int a = 0; a < 2; ++a)
#pragma unroll
        for (int b = 0; b < 2; ++b)
#pragma unroll
            for (int m = 0; m < 4; ++m)
#pragma unroll
                for (int n = 0; n < 2; ++n) acc[a][b][m][n] = (f32x4){0.f, 0.f, 0.f, 0.f};
    bf16x8 At[4][2], B0[2][2], B1[2][2];
    const char* cA = (const char*)g.A + (size_t)cur.pm * tstep; const char* cB = (const char*)g.Bt + (size_t)cur.pn * tstep;
    S.a_ready(cur);
    if constexpr (SP2) {
        PG8_STAGE(PG8_SB(0, 0), cB, voffB); PG8_STAGE(PG8_SB(0, 1), cB + hstep, voffB); PG8_STAGE(PG8_SA(0, 0), cA, voffA); PG8_STAGE(PG8_SA(0, 1), cA + hstep, voffA);
        if (wr == 1) PG8_BAR;
        PG8_WAIT_V(2); PG8_BAR;
        PG8_STAGE(PG8_SB(1, 0), cB + kstep, voffB); PG8_STAGE(PG8_SA(1, 0), cA + kstep, voffA); PG8_STAGE(PG8_SB(1, 1), cB + hstep + kstep, voffB);
        PG8_WAIT_V(6); PG8_BAR;
    } else {
        PG8_STAGE(PG8_SB(0, 0), cB, voffB); PG8_STAGE(PG8_SA(0, 0), cA, voffA); PG8_STAGE(PG8_SB(0, 1), cB + hstep, voffB); PG8_STAGE(PG8_SA(0, 1), cA + hstep, voffA);
        if (wr == 1) PG8_BAR;
        PG8_WAIT_V(4); PG8_BAR;
        PG8_STAGE(PG8_SB(1, 0), cB + kstep, voffB); PG8_STAGE(PG8_SA(1, 0), cA + kstep, voffA); PG8_STAGE(PG8_SB(1, 1), cB + hstep + kstep, voffB);
        PG8_WAIT_V(6); PG8_BAR;
    }
    for (;;) {
        const bool has_next = S.next(ui + 1, nxt);
        const char* nA = has_next ? (const char*)g.A + (size_t)nxt.pm * tstep : cA; const char* nB = has_next ? (const char*)g.Bt + (size_t)nxt.pn * tstep : cB;
        for (int t = 0; t < nt; t += 2) {
            const bool last = (t == nt - 2);
            const char* a1 = cA + (size_t)(t + 1) * kstep;
            const char* a2 = last ? nA : cA + (size_t)(t + 2) * kstep; const char* b2 = last ? nB : cB + (size_t)(t + 2) * kstep;
            const char* a3 = a2 + kstep; const char* b3 = b2 + kstep;
            if (last && has_next) S.a_ready(nxt);
            if constexpr (SP2) {
            PG8_LDB(B0, 0, 0); PG8_LDB(B1, 0, 1); PG8_SCHED; PG8_LDA(At, 0, 0); PG8_STAGE(PG8_SA(1, 1), a1 + hstep, voffA);
            PG8_WAIT_V(8); PG8_WAIT_L(0); PG8_BAR; PG8_MMA(0, 0, At, B0); PG8_MMA(0, 1, At, B1); PG8_BAR; PG8_SCHED;
            PG8_LDA(At, 0, 1); PG8_STAGE(PG8_SB(0, 0), b2, voffB); PG8_STAGE(PG8_SB(0, 1), b2 + hstep, voffB); PG8_STAGE(PG8_SA(0, 0), a2, voffA);
            PG8_WAIT_V(8); PG8_WAIT_L(0); PG8_BAR; PG8_MMA(1, 0, At, B0); PG8_MMA(1, 1, At, B1); PG8_BAR; PG8_SCHED;
            PG8_LDB(B0, 1, 0); PG8_LDB(B1, 1, 1); PG8_SCHED; PG8_LDA(At, 1, 0); PG8_STAGE(PG8_SA(0, 1), a2 + hstep, voffA);
            PG8_WAIT_V(8); PG8_WAIT_L(0); PG8_BAR; PG8_MMA(0, 0, At, B0); PG8_MMA(0, 1, At, B1); PG8_BAR; PG8_SCHED;
            PG8_LDA(At, 1, 1); PG8_STAGE(PG8_SB(1, 0), b3, voffB); PG8_STAGE(PG8_SB(1, 1), b3 + hstep, voffB); PG8_STAGE(PG8_SA(1, 0), a3, voffA);
            PG8_WAIT_V(8); PG8_WAIT_L(0); PG8_BAR; PG8_MMA(1, 0, At, B0); PG8_MMA(1, 1, At, B1); PG8_BAR; PG8_SCHED;
            } else {
            PG8_LDB(B0, 0, 0); PG8_SCHED; PG8_LDA(At, 0, 0); PG8_STAGE(PG8_SA(1, 1), a1 + hstep, voffA);
            PG8_WAIT_L(8); PG8_BAR; PG8_WAIT_L(0); PG8_MMA(0, 0, At, B0); PG8_BAR; PG8_SCHED;
            PG8_LDB(B1, 0, 1); PG8_STAGE(PG8_SB(0, 0), b2, voffB);
            PG8_BAR; PG8_WAIT_L(0); PG8_MMA(0, 1, At, B1); PG8_BAR;
            PG8_LDA(At, 0, 1); PG8_STAGE(PG8_SA(0, 0), a2, voffA);
            PG8_BAR; PG8_WAIT_L(0); PG8_MMA(1, 0, At, B0); PG8_BAR; PG8_SCHED;
            PG8_STAGE(PG8_SB(0, 1), b2 + hstep, voffB);
            PG8_WAIT_V(6); PG8_BAR; PG8_MMA(1, 1, At, B1); PG8_BAR;
            PG8_LDB(B0, 1, 0); PG8_SCHED; PG8_LDA(At, 1, 0); PG8_STAGE(PG8_SA(0, 1), a2 + hstep, voffA);
            PG8_WAIT_L(8); PG8_BAR; PG8_WAIT_L(0); PG8_MMA(0, 0, At, B0); PG8_BAR; PG8_SCHED;
            PG8_LDB(B1, 1, 1); PG8_STAGE(PG8_SB(1, 0), b3, voffB);
            PG8_BAR; PG8_WAIT_L(0); PG8_MMA(0, 1, At, B1); PG8_BAR;
            PG8_LDA(At, 1, 1); PG8_STAGE(PG8_SA(1, 0), a3, voffA);
            PG8_BAR; PG8_WAIT_L(0); PG8_MMA(1, 0, At, B0); PG8_BAR; PG8_SCHED;
            PG8_STAGE(PG8_SB(1, 1), b3 + hstep, voffB);
            PG8_WAIT_V(6); PG8_BAR; PG8_MMA(1, 1, At, B1); PG8_BAR;
            }
        }
        if constexpr (ALIGN_EPI) { if (wr == 0) PG8_BAR; }
        if constexpr (!Epi::AFTER_DRAIN) { E(acc, cur, wr, wc, fr, fq, est, has_next, nxt, lds, tid); S.done(cur); }
        if (!has_next) break;
#pragma unroll
        for (int a = 0; a < 2; ++a)
#pragma unroll
            for (int b = 0; b < 2; ++b)
#pragma unroll
                for (int m = 0; m < 4; ++m)
#pragma unroll
                    for (int n = 0; n < 2; ++n) acc[a][b][m][n] = (f32x4){0.f, 0.f, 0.f, 0.f};
        cur = nxt; cA = nA; cB = nB; ++ui;
        if constexpr (ALIGN_EPI) { if (wr == 1) PG8_BAR; }
    }
    PG8_WAIT_V(0);
    if constexpr (!ALIGN_EPI) { if (wr == 0) PG8_BAR; }
    PG8_BAR;
    if constexpr (Epi::AFTER_DRAIN) { E.fused(acc, cur, wr, wc, fr, fq, lds, wid, lane); S.done(cur); }
#undef PG8_SA
#undef PG8_SB
#undef PG8_STAGE
#undef PG8_LDA
#undef PG8_LDB
#undef PG8_MMA
#undef PG8_WAIT_V
#undef PG8_WAIT_L
#undef PG8_BAR
#undef PG8_SCHED
}
}

using pg8::bf16_t; using pg8::bf16x8; using pg8::f32x4; using pg8::Unit; using pg8::f32x2; using pg8::u32x4;
typedef unsigned u32x2 __attribute__((ext_vector_type(2)));

constexpr int D = 2048, NPROMPT = 32768, NSAMP = 256, NROWS = 33024;
constexpr int NA = 7168, NB = 5120, DMIX = 3072, DFF = 5632, DFF2 = 11264;
constexpr int CH = 16384, CHL = CH + NSAMP;
constexpr float EPS = 1e-6f;
constexpr int LDS_BYTES = pg8::STAGE_BYTES + 16;

constexpr size_t WS_WINA = 0;
constexpr size_t WS_WINB = WS_WINA + (size_t)NA * D * 2;
constexpr size_t WS_WOUT = WS_WINB + (size_t)NB * D * 2;
constexpr size_t WS_WUP = WS_WOUT + (size_t)2 * D * DMIX * 2;
constexpr size_t WS_WDOWN = WS_WUP + (size_t)2 * DFF2 * D * 2;
constexpr size_t WS_WMEM = WS_WDOWN + (size_t)2 * D * DFF * 2;
constexpr size_t WS_WM = WS_WMEM + (size_t)4096 * D * 2;
constexpr size_t WS_XB = WS_WM + (size_t)8 * 128 * 128 * 2;
constexpr size_t WS_MEMB = WS_XB + (size_t)NROWS * D * 2;
constexpr size_t WS_KB = WS_MEMB + (size_t)512 * D * 2;
constexpr size_t WS_VT = WS_KB + (size_t)20 * 256 * 1024 * 2;
constexpr size_t WS_SS = WS_VT + (size_t)20 * 256 * 1024 * 2;
constexpr size_t WS_SSM = WS_SS + (size_t)NROWS * 32 * 4;
constexpr size_t WS_STATS = WS_SSM + (size_t)512 * 32 * 4;
constexpr size_t WS_BAR = WS_STATS + (size_t)NROWS * 8;
constexpr size_t WS_BIG = WS_BAR + 16384;
static_assert(XCD_BAR_WORDS * 4 <= 16384, "barrier words");
constexpr size_t BIG_PROJ = 0, BIG_YCAT = (size_t)CHL * NA * 2, BIG_ZS = BIG_YCAT + (size_t)NROWS * DMIX * 2, BIG_HALO = BIG_ZS + (size_t)NSAMP * DFF2 * 2, BIG_H = 0;
constexpr size_t WS_END = WS_BIG + BIG_HALO + (size_t)(NPROMPT / 64) * 4 * DFF2 * 4;
static_assert((size_t)NROWS * DFF * 2 <= BIG_ZS, "h overlays proj and ycat only");
static_assert(WS_END <= ((size_t)1 << 30), "workspace over 1 GiB");

constexpr size_t O_YP = 0, O_YS = 67108864, O_CAP = 67633152, O_FCP = 67641344, O_MKP = 67731456, O_MVP = 68780032, O_CAS = 69828608, O_FCS = 69861376, O_GVS = 70221824;

struct Params { const float* in[25]; float* out; unsigned char* ws; };
enum { I_XP = 0, I_XS, I_MEM, I_CCA, I_CFC, I_CMK, I_CMV, I_GMIX, I_GMEM, I_WMK, I_WMV, I_WINA, I_CAW, I_WINB, I_GNG, I_GNB, I_GWS, I_GBIAS, I_WOUT, I_GFFN, I_WUP, I_FCW, I_FCB, I_WDOWN, I_GFIN };

__device__ __forceinline__ float bf_lo(unsigned u) { return __uint_as_float(u << 16); }
__device__ __forceinline__ float bf_hi(unsigned u) { return __uint_as_float(u & 0xffff0000u); }
__device__ __forceinline__ unsigned pk(float a, float b) { return pg8::cvt_pk_bf16(a, b); }
__device__ __forceinline__ void unpack8(const u32x4 r, float (&f)[8]) { f[0] = bf_lo(r.x); f[1] = bf_hi(r.x); f[2] = bf_lo(r.y); f[3] = bf_hi(r.y); f[4] = bf_lo(r.z); f[5] = bf_hi(r.z); f[6] = bf_lo(r.w); f[7] = bf_hi(r.w); }
__device__ __forceinline__ u32x4 pack8(const float (&f)[8]) { u32x4 w; w.x = pk(f[0], f[1]); w.y = pk(f[2], f[3]); w.z = pk(f[4], f[5]); w.w = pk(f[6], f[7]); return w; }
__device__ __forceinline__ int lrow(int row, int rows0) { return row < NPROMPT ? row - rows0 : row - NPROMPT + CH; }

template <int X1, int X2> __device__ __forceinline__ float rowscale(const float* ss, int row, int part) {
    const f32x4* q = (const f32x4*)(ss + (size_t)row * 32 + part * 8);
    const f32x4 a = q[0], b = q[1];
    float s = ((a[0] + a[1]) + (a[2] + a[3])) + ((b[0] + b[1]) + (b[2] + b[3]));
    s += __shfl_xor(s, X1); s += __shfl_xor(s, X2);
    return rsqrtf(s * (1.0f / 2048.0f) + EPS);
}

struct OpScale {
    static constexpr bool SUMSQ = false, NEEDS_RS = true, PRELOAD = false;
    const float* ss; bf16_t* dst; int ld, rows0, gelu_cols;
    struct Row { bf16_t* dp; float rs; bool gelu; };
    __device__ __forceinline__ const float* ssin() const { return ss; }
    __device__ __forceinline__ Row begin_row(int row, int col0, float rs) const { Row r; r.rs = rs; r.dp = dst + (size_t)lrow(row, rows0) * ld + col0; r.gelu = col0 < gelu_cols; return r; }
    __device__ __forceinline__ f32x4 load4(const Row&, int) const { return (f32x4){0.f, 0.f, 0.f, 0.f}; }
    __device__ __forceinline__ f32x4 act(const Row& r, f32x4 v) const {
        v = v * r.rs;
        if (r.gelu) { const f32x2 a = pg8::gelu_pk((f32x2){v[0], v[1]}), b = pg8::gelu_pk((f32x2){v[2], v[3]}); v = (f32x4){a.x, a.y, b.x, b.y}; }
        return v;
    }
    __device__ __forceinline__ void store4(const Row& r, int coff, f32x4 v, f32x4, float&) const {
        v = act(r, v); u32x2 w; w.x = pk(v[0], v[1]); w.y = pk(v[2], v[3]);
        *(u32x2*)(r.dp + coff) = w;
    }
    __device__ __forceinline__ void store8(const Row& r, int coff, f32x4 v0, f32x4 v1, f32x4, f32x4, float&) const {
        v0 = act(r, v0); v1 = act(r, v1); u32x4 w; w.x = pk(v0[0], v0[1]); w.y = pk(v0[2], v0[3]); w.z = pk(v1[0], v1[1]); w.w = pk(v1[2], v1[3]);
        *(u32x4*)(r.dp + coff) = w;
    }
    __device__ __forceinline__ void end_row(int, int, float) const {}
};
struct OpResid {
    static constexpr bool SUMSQ = true, NEEDS_RS = false, PRELOAD = true;
    bf16_t* xb; float* ss;
    struct Row { unsigned xo; };
    __device__ __forceinline__ const float* ssin() const { return nullptr; }
    __device__ __forceinline__ Row begin_row(int row, int col0, float) const { Row r; r.xo = (unsigned)row * D + col0; return r; }
    __device__ __forceinline__ f32x4 load4(const Row& r, int coff) const { const u32x2 w = *(const u32x2*)(xb + (size_t)r.xo + coff); return (f32x4){bf_lo(w.x), bf_hi(w.x), bf_lo(w.y), bf_hi(w.y)}; }
    __device__ __forceinline__ void store4(const Row& r, int coff, f32x4 v, f32x4 pre, float& sq) const {
        const f32x4 x = pre + v;
        u32x2 w; w.x = pk(x[0], x[1]); w.y = pk(x[2], x[3]);
        *(u32x2*)(xb + (size_t)r.xo + coff) = w;
        sq += (x[0] * x[0] + x[1] * x[1]) + (x[2] * x[2] + x[3] * x[3]);
    }
    __device__ __forceinline__ void store8(const Row& r, int coff, f32x4 v0, f32x4 v1, f32x4 p0, f32x4 p1, float& sq) const {
        const f32x4 x0 = p0 + v0, x1 = p1 + v1;
        u32x4 w; w.x = pk(x0[0], x0[1]); w.y = pk(x0[2], x0[3]); w.z = pk(x1[0], x1[1]); w.w = pk(x1[2], x1[3]);
        *(u32x4*)(xb + (size_t)r.xo + coff) = w;
        sq += ((x0[0] * x0[0] + x0[1] * x0[1]) + (x0[2] * x0[2] + x0[3] * x0[3])) + ((x1[0] * x1[0] + x1[1] * x1[1]) + (x1[2] * x1[2] + x1[3] * x1[3]));
    }
    __device__ __forceinline__ void end_row(int row, int part, float sq) const { ss[(size_t)row * 32 + part] = sq; }
};
struct OpMemKV {
    static constexpr bool SUMSQ = false, NEEDS_RS = true, PRELOAD = false;
    const float* ssm; float* out_k; float* out_v; bf16_t* Kb; bf16_t* Vt;
    struct Row { float* o; bf16_t* kb; bf16_t* vt; float rs; };
    __device__ __forceinline__ const float* ssin() const { return ssm; }
    __device__ __forceinline__ Row begin_row(int row, int col0, float rs) const {
        Row r; r.rs = rs;
        const int layer = col0 >> 11, isv = (col0 >> 10) & 1, c = col0 & 1023, b = row >> 8, m = row & 255, bbi = layer * 10 + 8 + b;
        r.o = (isv ? out_v : out_k) + ((size_t)((layer * 2 + b) * 256 + m)) * 1024 + c;
        r.kb = isv ? nullptr : Kb + ((size_t)bbi * 256 + m) * 1024 + c;
        r.vt = Vt + ((size_t)bbi * 1024 + c) * 256 + m;
        return r;
    }
    __device__ __forceinline__ f32x4 load4(const Row&, int) const { return (f32x4){0.f, 0.f, 0.f, 0.f}; }
    __device__ __forceinline__ void store4(const Row& r, int coff, f32x4 v, f32x4, float&) const {
        v = v * r.rs;
        *(f32x4*)(r.o + coff) = v;
        const unsigned w0 = pk(v[0], v[1]), w1 = pk(v[2], v[3]);
        if (r.kb) { u32x2 w; w.x = w0; w.y = w1; *(u32x2*)(r.kb + coff) = w; }
        else { bf16_t* t = r.vt + (size_t)coff * 256; t[0] = (bf16_t)(w0 & 0xffffu); t[256] = (bf16_t)(w0 >> 16); t[512] = (bf16_t)(w1 & 0xffffu); t[768] = (bf16_t)(w1 >> 16); }
    }
    __device__ __forceinline__ void end_row(int, int, float) const {}
};

template <class Op> struct EpiG {
    static constexpr bool PERM = true, APERM = false, AFTER_DRAIN = false;
    Op op; int row_base;
    struct State { int pm; f32x4 ra, rb; };
    __device__ __forceinline__ void init_state(State& st, const Unit&, PG8_LAS unsigned char*, int) const {
        st.pm = -1; st.ra = (f32x4){1.f, 1.f, 1.f, 1.f}; st.rb = st.ra;
    }
    __device__ __forceinline__ void operator()(const f32x4 (&acc)[2][2][4][2], const Unit& u, int wr, int wc, int fr, int fq, State& st, bool, const Unit&, PG8_LAS unsigned char*, int) const {
        const int row0 = row_base + u.pm * 256 + wr * 64 + fr, col0 = u.pn * 256 + wc * 32 + 8 * fq;
        if constexpr (Op::NEEDS_RS) {
            if (u.pm != st.pm) {
                const float* sp = op.ssin() + (size_t)row0 * 32 + fq * 8;
                f32x4 pa[8], pb[8];
#pragma unroll
                for (int i = 0; i < 8; ++i) { const float* q = sp + (size_t)((i >> 2) * 128 + (i & 3) * 16) * 32; pa[i] = *(const f32x4*)q; pb[i] = *(const f32x4*)(q + 4); }
#pragma unroll
                for (int i = 0; i < 8; ++i) { float s = ((pa[i][0] + pa[i][1]) + (pa[i][2] + pa[i][3])) + ((pb[i][0] + pb[i][1]) + (pb[i][2] + pb[i][3]));
                    s += __shfl_xor(s, 16); s += __shfl_xor(s, 32); const float r = rsqrtf(s * (1.0f / 2048.0f) + EPS); if (i < 4) st.ra[i & 3] = r; else st.rb[i & 3] = r; }
                st.pm = u.pm;
            }
        }
        if constexpr (Op::PRELOAD) {
#pragma unroll
            for (int ai = 0; ai < 2; ++ai) {
                typename Op::Row rc[4]; f32x4 pre[4][4];
#pragma unroll
                for (int m = 0; m < 4; ++m) rc[m] = op.begin_row(row0 + ai * 128 + m * 16, col0, 1.f);
#pragma unroll
                for (int m = 0; m < 4; ++m)
#pragma unroll
                    for (int bj = 0; bj < 2; ++bj) { pre[m][bj * 2] = op.load4(rc[m], bj * 128); pre[m][bj * 2 + 1] = op.load4(rc[m], bj * 128 + 4); }
#pragma unroll
                for (int m = 0; m < 4; ++m) {
                    float sq = 0.f;
#pragma unroll
                    for (int bj = 0; bj < 2; ++bj) op.store8(rc[m], bj * 128, acc[ai][bj][m][0], acc[ai][bj][m][1], pre[m][bj * 2], pre[m][bj * 2 + 1], sq);
                    if (Op::SUMSQ) { sq += __shfl_xor(sq, 16); sq += __shfl_xor(sq, 32); if (fq == 0) op.end_row(row0 + ai * 128 + m * 16, u.pn * 4 + wc, sq); }
                }
                asm volatile("" ::: "memory");
            }
        } else {
            const f32x4 z4 = (f32x4){0.f, 0.f, 0.f, 0.f};
#pragma unroll
            for (int ai = 0; ai < 2; ++ai)
#pragma unroll
                for (int m = 0; m < 4; ++m) {
                    const typename Op::Row rc = op.begin_row(row0 + ai * 128 + m * 16, col0, ai ? st.rb[m] : st.ra[m]); float sq = 0.f;
#pragma unroll
                    for (int bj = 0; bj < 2; ++bj) op.store8(rc, bj * 128, acc[ai][bj][m][0], acc[ai][bj][m][1], z4, z4, sq);
                }
        }
    }
};

__device__ __forceinline__ float dpp_shr1(float v) { return __builtin_bit_cast(float, __builtin_amdgcn_update_dpp(0, __builtin_bit_cast(int, v), 0x111, 0xf, 0xf, true)); }
struct EpiFfn {
    static constexpr bool PERM = true, APERM = true, AFTER_DRAIN = false;
    const float* ss; const float* cw; const float* cb; bf16_t* h; float* halo; int row_base;
    struct State { int pm; f32x4 ra, rb; int slot; };
    __device__ __forceinline__ const float* slice_src(int pn, int tid) const {
        const int a = tid >> 6, cl = (tid & 63) * 2;
        const float* base = (a & 3) < 3 ? cw + (size_t)(a & 3) * DFF2 : cb;
        return base + (a >> 2) * DFF + pn * 128 + cl;
    }
    __device__ __forceinline__ void init_state(State& st, const Unit& u, PG8_LAS unsigned char* lds, int tid) const {
        st.pm = -1; st.slot = 0; st.ra = (f32x4){1.f, 1.f, 1.f, 1.f}; st.rb = st.ra;
    }
    __device__ __forceinline__ void operator()(const f32x4 (&acc)[2][2][4][2], const Unit& u, int wr, int wc, int fr, int fq, State& st, bool has_next, const Unit& nxt, PG8_LAS unsigned char* lds, int tid) const {
        const int lrow0 = u.pm * 256 + wr * 64 + 4 * fr, c0 = u.pn * 128 + wc * 32 + 8 * fq;
        if (u.pm != st.pm) {
            const float* sp = ss + (size_t)(row_base + lrow0) * 32 + fq * 8;
            f32x4 pa[8], pb[8];
#pragma unroll
            for (int i = 0; i < 8; ++i) { const float* q = sp + (size_t)((i >> 2) * 128 + (i & 3)) * 32; pa[i] = *(const f32x4*)q; pb[i] = *(const f32x4*)(q + 4); }
#pragma unroll
            for (int i = 0; i < 8; ++i) { float s = ((pa[i][0] + pa[i][1]) + (pa[i][2] + pa[i][3])) + ((pb[i][0] + pb[i][1]) + (pb[i][2] + pb[i][3]));
                s += __shfl_xor(s, 16); s += __shfl_xor(s, 32); const float r = rsqrtf(s * (1.0f / 2048.0f) + EPS); if (i < 4) st.ra[i & 3] = r; else st.rb[i & 3] = r; }
            st.pm = u.pm;
        }
        u32x2 res[8];
#pragma unroll
        for (int n = 0; n < 2; ++n) {
            const int cc = c0 + 4 * n;
            const f32x4 wa0 = *(const f32x4*)(cw + cc), wa1 = *(const f32x4*)(cw + DFF2 + cc), wa2 = *(const f32x4*)(cw + 2 * DFF2 + cc), ba = *(const f32x4*)(cb + cc);
            const f32x4 wg0 = *(const f32x4*)(cw + DFF + cc), wg1 = *(const f32x4*)(cw + DFF2 + DFF + cc), wg2 = *(const f32x4*)(cw + 2 * DFF2 + DFF + cc), bg = *(const f32x4*)(cb + DFF + cc);
#pragma unroll
            for (int ai = 0; ai < 2; ++ai) {
                const int blk = u.pm * 4 + ai * 2 + wr;
                f32x4 za[4], zg[4];
#pragma unroll
                for (int m = 0; m < 4; ++m) { const float r = ai ? st.rb[m] : st.ra[m]; za[m] = acc[ai][0][m][n] * r; zg[m] = acc[ai][1][m][n] * r; }
                f32x4 la2, la3, lg2, lg3;
#pragma unroll
                for (int j = 0; j < 4; ++j) { la2[j] = dpp_shr1(za[2][j]); la3[j] = dpp_shr1(za[3][j]); lg2[j] = dpp_shr1(zg[2][j]); lg3[j] = dpp_shr1(zg[3][j]); }
#pragma unroll
                for (int m = 0; m < 4; ++m) {
                    const f32x4 p2a = m == 0 ? la2 : (m == 1 ? la3 : za[m >= 2 ? m - 2 : 0]), p1a = m == 0 ? la3 : za[m >= 1 ? m - 1 : 0];
                    const f32x4 p2g = m == 0 ? lg2 : (m == 1 ? lg3 : zg[m >= 2 ? m - 2 : 0]), p1g = m == 0 ? lg3 : zg[m >= 1 ? m - 1 : 0];
                    const f32x4 ca = wa0 * p2a + wa1 * p1a + wa2 * za[m] + ba;
                    const f32x4 cg = wg0 * p2g + wg1 * p1g + wg2 * zg[m] + bg;
                    f32x4 o;
#pragma unroll
                    for (int j = 0; j < 4; ++j) o[j] = ca[j] * cg[j] * __builtin_amdgcn_rcpf(1.0f + __builtin_amdgcn_exp2f(-1.44269504089f * cg[j]));
                    if ((fr == 0 && m < 2) || (fr == 15 && m >= 2)) { float* hp = halo + ((size_t)(blk * 4 + m)) * DFF2 + cc; *(f32x4*)hp = za[m]; *(f32x4*)(hp + DFF) = zg[m]; }
                    u32x2 w; w.x = pk(o[0], o[1]); w.y = pk(o[2], o[3]);
                    if (n == 0) res[ai * 4 + m] = w;
                    else { u32x4 w4; w4.x = res[ai * 4 + m].x; w4.y = res[ai * 4 + m].y; w4.z = w.x; w4.w = w.y; *(u32x4*)(h + (size_t)(lrow0 + ai * 128 + m) * DFF + c0) = w4; }
                }
            }
        }
    }
};

constexpr int RP = 68;
template <class Op>
__device__ __forceinline__ void small_gemm(const bf16_t* A, int lda, const bf16_t* Bt, int M, int N, int K, const Op& op, int row_base, unsigned char* shm) {
    const int tid = otid(), lane = tid & 63, wid = tid >> 6, fr = lane & 15, fq = lane >> 4;
    float* red = (float*)shm;
    const int nmt = M / 32, ntiles = nmt * (N / 64), kw = K / 8;
    for (int t = blockIdx.x; t < ntiles; t += gridDim.x) {
        const int tm = t % nmt, tn = t / nmt;
        const bf16_t* ap = A + (size_t)(tm * 32 + fr) * lda + wid * kw + fq * 8;
        const bf16_t* bp = Bt + (size_t)(tn * 64 + fr) * K + wid * kw + fq * 8;
        f32x4 acc[2][4];
#pragma unroll
        for (int mt = 0; mt < 2; ++mt)
#pragma unroll
            for (int n = 0; n < 4; ++n) acc[mt][n] = (f32x4){0.f, 0.f, 0.f, 0.f};
#pragma unroll 4
        for (int k = 0; k < kw; k += 32) {
            const bf16x8 a0 = *(const bf16x8*)(ap + k), a1 = *(const bf16x8*)(ap + (size_t)16 * lda + k);
#pragma unroll
            for (int n = 0; n < 4; ++n) { const bf16x8 b = *(const bf16x8*)(bp + (size_t)n * 16 * K + k);
                acc[0][n] = __builtin_amdgcn_mfma_f32_16x16x32_bf16(b, a0, acc[0][n], 0, 0, 0); acc[1][n] = __builtin_amdgcn_mfma_f32_16x16x32_bf16(b, a1, acc[1][n], 0, 0, 0); }
        }
#pragma unroll
        for (int mt = 0; mt < 2; ++mt)
#pragma unroll
            for (int n = 0; n < 4; ++n) *(f32x4*)(red + (wid * 32 + mt * 16 + fr) * RP + n * 16 + 4 * fq) = acc[mt][n];
        __syncthreads();
        const int rl = wid * 4 + (lane >> 4), c4 = (lane & 15) * 4;
        f32x4 v = *(const f32x4*)(red + rl * RP + c4);
#pragma unroll
        for (int w = 1; w < 8; ++w) v += *(const f32x4*)(red + (w * 32 + rl) * RP + c4);
        const int row = row_base + tm * 32 + rl;
        float rs = 1.f; if (Op::NEEDS_RS) rs = rowscale<1, 2>(op.ssin(), row, lane & 3);
        const typename Op::Row rc = op.begin_row(row, tn * 64 + c4, rs); float sq = 0.f;
        f32x4 pre = (f32x4){0.f, 0.f, 0.f, 0.f}; if (Op::PRELOAD) pre = op.load4(rc, 0);
        op.store4(rc, 0, v, pre, sq);
        if (Op::SUMSQ) { sq += __shfl_xor(sq, 1); sq += __shfl_xor(sq, 2); sq += __shfl_xor(sq, 4); sq += __shfl_xor(sq, 8); if ((lane & 15) == 0) op.end_row(row, tn, sq); }
        __syncthreads();
    }
}

__device__ __forceinline__ int up_perm(int n) { return n < DFF ? (n >> 7) * 256 + (n & 127) : ((n - DFF) >> 7) * 256 + 128 + ((n - DFF) & 127); }
__device__ __forceinline__ void tjob(const float* src, const float* gain, bf16_t* dst, int K, int N, int nb, size_t sbs, size_t dbs, int& tile0, float* lf, bool perm = false) {
    const int tid = otid(), G = gridDim.x;
    const int nkt = K / 256, nnt = N / 64, tpb = nkt * nnt, ntile = tpb * nb;
    int first = ((int)blockIdx.x - tile0) % G; if (first < 0) first += G;
    for (int tt = first; tt < ntile; tt += G) {
        const int batch = tt / tpb, rem = tt % tpb, kt = rem % nkt, nt = rem / nkt;
        const float* s = src + (size_t)batch * sbs + (size_t)(kt * 256) * N + nt * 64;
        f32x4 v[8];
#pragma unroll
        for (int i = 0; i < 8; ++i) { const int idx = tid + 512 * i, kr = idx >> 4, c4 = idx & 15; v[i] = *(const f32x4*)(s + (size_t)kr * N + c4 * 4); }
#pragma unroll
        for (int i = 0; i < 8; ++i) {
            const int idx = tid + 512 * i, kr = idx >> 4, c4 = idx & 15;
            const float gk = gain ? gain[kt * 256 + kr] : 1.0f;
            float* l = lf + kr * 65 + c4 * 4; l[0] = v[i][0] * gk; l[1] = v[i][1] * gk; l[2] = v[i][2] * gk; l[3] = v[i][3] * gk;
        }
        __syncthreads();
        bf16_t* d = dst + (size_t)batch * dbs + (size_t)(perm ? up_perm(nt * 64) : nt * 64) * K + kt * 256;
#pragma unroll
        for (int i = 0; i < 4; ++i) {
            const int idx = tid + 512 * i, k8 = (idx >> 10) * 16 + (idx & 15), n = (idx >> 4) & 63;
            const float* l = lf + (k8 * 8) * 65 + n;
            u32x4 w; w.x = pk(l[0], l[65]); w.y = pk(l[130], l[195]); w.z = pk(l[260], l[325]); w.w = pk(l[390], l[455]);
            *(u32x4*)(d + (size_t)n * K + k8 * 8) = w;
        }
        __syncthreads();
    }
    tile0 += ntile;
}

__device__ __forceinline__ void prep_phase(const Params& p, unsigned char* shm) {
    unsigned char* ws = p.ws; float* lf = (float*)shm;
    const int tid = otid(), lane = tid & 63, wid = tid >> 6, G = gridDim.x;
    int t0 = 0;
    tjob(p.in[I_WINA], p.in[I_GMIX], (bf16_t*)(ws + WS_WINA), D, NA, 1, 0, 0, t0, lf);
    tjob(p.in[I_WINB], p.in[I_GMIX] + D, (bf16_t*)(ws + WS_WINB), D, NB, 1, 0, 0, t0, lf);
    tjob(p.in[I_WOUT], nullptr, (bf16_t*)(ws + WS_WOUT), DMIX, D, 2, (size_t)DMIX * D, (size_t)DMIX * D, t0, lf);
    tjob(p.in[I_WUP], p.in[I_GFFN], (bf16_t*)(ws + WS_WUP), D, DFF2, 1, 0, 0, t0, lf, true);
    tjob(p.in[I_WUP] + (size_t)D * DFF2, p.in[I_GFFN] + D, (bf16_t*)(ws + WS_WUP) + (size_t)D * DFF2, D, DFF2, 1, 0, 0, t0, lf, true);
    tjob(p.in[I_WDOWN], nullptr, (bf16_t*)(ws + WS_WDOWN), DFF, D, 2, (size_t)DFF * D, (size_t)DFF * D, t0, lf);
    tjob(p.in[I_WMK], p.in[I_GMEM], (bf16_t*)(ws + WS_WMEM), D, 1024, 1, 0, 0, t0, lf);
    tjob(p.in[I_WMV], p.in[I_GMEM], (bf16_t*)(ws + WS_WMEM) + (size_t)1024 * D, D, 1024, 1, 0, 0, t0, lf);
    tjob(p.in[I_WMK] + (size_t)D * 1024, p.in[I_GMEM] + D, (bf16_t*)(ws + WS_WMEM) + (size_t)2048 * D, D, 1024, 1, 0, 0, t0, lf);
    tjob(p.in[I_WMV] + (size_t)D * 1024, p.in[I_GMEM] + D, (bf16_t*)(ws + WS_WMEM) + (size_t)3072 * D, D, 1024, 1, 0, 0, t0, lf);
    tjob(p.in[I_CMV], nullptr, (bf16_t*)(ws + WS_VT), 256, 1024, 8, (size_t)262144, (size_t)262144, t0, lf);
    tjob(p.in[I_CMV] + (size_t)8 * 262144, nullptr, (bf16_t*)(ws + WS_VT) + (size_t)10 * 262144, 256, 1024, 8, (size_t)262144, (size_t)262144, t0, lf);
    {
        bf16_t* xb = (bf16_t*)(ws + WS_XB); bf16_t* memb = (bf16_t*)(ws + WS_MEMB); float* ss = (float*)(ws + WS_SS); float* ssm = (float*)(ws + WS_SSM);
        for (int row = blockIdx.x * 8 + wid; row < NROWS + 512; row += G * 8) {
            const float* src; bf16_t* db; float* sp;
            if (row < NPROMPT) { src = p.in[I_XP] + (size_t)row * D; db = xb + (size_t)row * D; sp = ss + (size_t)row * 32; }
            else if (row < NROWS) { src = p.in[I_XS] + (size_t)(row - NPROMPT) * D; db = xb + (size_t)row * D; sp = ss + (size_t)row * 32; }
            else { src = p.in[I_MEM] + (size_t)(row - NROWS) * D; db = memb + (size_t)(row - NROWS) * D; sp = ssm + (size_t)(row - NROWS) * 32; }
            float sq = 0.f;
#pragma unroll
            for (int i = 0; i < 8; ++i) {
                const f32x4 v = *(const f32x4*)(src + (i * 64 + lane) * 4);
                sq += (v[0] * v[0] + v[1] * v[1]) + (v[2] * v[2] + v[3] * v[3]);
                u32x2 w; w.x = pk(v[0], v[1]); w.y = pk(v[2], v[3]);
                *(u32x2*)(db + (i * 64 + lane) * 4) = w;
            }
#pragma unroll
            for (int o = 32; o >= 1; o >>= 1) sq += __shfl_xor(sq, o);
            if (lane < 32) sp[lane] = lane == 0 ? sq : 0.f;
        }
    }
    {
        bf16_t* Kb = (bf16_t*)(ws + WS_KB);
        const size_t n4 = (size_t)2 * 8 * 262144 / 4;
        for (size_t i = (size_t)blockIdx.x * 512 + tid; i < n4; i += (size_t)G * 512) {
            const f32x4 v = *(const f32x4*)(p.in[I_CMK] + i * 4);
            const size_t e = i * 4, lb = e / 262144, r = e % 262144, layer = lb / 8, b = lb % 8;
            u32x2 w; w.x = pk(v[0], v[1]); w.y = pk(v[2], v[3]);
            *(u32x2*)(Kb + (layer * 10 + b) * 262144 + r) = w;
        }
        bf16_t* Wm = (bf16_t*)(ws + WS_WM);
        for (int i = blockIdx.x * 512 + tid; i < 8 * 128 * 128; i += G * 512) {
            const int s = i & 127, t = (i >> 7) & 127;
            const float v = s <= t ? p.in[I_GWS][i] : 0.f;
            Wm[i] = (bf16_t)(pk(v, 0.f) & 0xffffu);
        }
    }
}

__device__ __forceinline__ void mixa_rows(const Params& p, const bf16_t* proj, bf16_t* ycat, int rows0, int r0, int r1, int seq0, int seq1, const float* prev, float* state_out, int ch0) {
    const float* cw = p.in[I_CAW];
    float w0[8], w1[8], w2[8], zm2[8], zm1[8];
#pragma unroll
    for (int i = 0; i < 8; ++i) { w0[i] = cw[ch0 + i]; w1[i] = cw[D + ch0 + i]; w2[i] = cw[2 * D + ch0 + i]; }
    {
        const int ra = r0 - 2, rb = r0 - 1;
        if (ra >= seq0) { const bf16_t* q = proj + (size_t)lrow(ra, rows0) * NA; float c[8], h[8]; unpack8(*(const u32x4*)(q + D + ch0), c); unpack8(*(const u32x4*)(q + 2 * D + ch0), h);
#pragma unroll
            for (int i = 0; i < 8; ++i) zm2[i] = c[i] * h[i]; }
        else {
#pragma unroll
            for (int i = 0; i < 8; ++i) zm2[i] = prev ? prev[(ra - seq0 + 2) * D + ch0 + i] : 0.f; }
        if (rb >= seq0) { const bf16_t* q = proj + (size_t)lrow(rb, rows0) * NA; float c[8], h[8]; unpack8(*(const u32x4*)(q + D + ch0), c); unpack8(*(const u32x4*)(q + 2 * D + ch0), h);
#pragma unroll
            for (int i = 0; i < 8; ++i) zm1[i] = c[i] * h[i]; }
        else {
#pragma unroll
            for (int i = 0; i < 8; ++i) zm1[i] = prev ? prev[(rb - seq0 + 2) * D + ch0 + i] : 0.f; }
    }
    int r = r0;
    for (; r + 4 <= r1; r += 4) {
        u32x4 vb[4], vc[4], vh[4];
#pragma unroll
        for (int k = 0; k < 4; ++k) { const bf16_t* q = proj + (size_t)lrow(r + k, rows0) * NA; vb[k] = *(const u32x4*)(q + ch0); vc[k] = *(const u32x4*)(q + D + ch0); vh[k] = *(const u32x4*)(q + 2 * D + ch0); }
#pragma unroll
        for (int k = 0; k < 4; ++k) {
            float b[8], c[8], h[8], y[8], z[8];
            unpack8(vb[k], b); unpack8(vc[k], c); unpack8(vh[k], h);
#pragma unroll
            for (int i = 0; i < 8; ++i) { z[i] = c[i] * h[i]; y[i] = b[i] * (w0[i] * zm2[i] + w1[i] * zm1[i] + w2[i] * z[i]); zm2[i] = zm1[i]; zm1[i] = z[i]; }
            *(u32x4*)(ycat + (size_t)(r + k) * DMIX + ch0) = pack8(y);
            if (r + k >= seq1 - 2) { float* so = state_out + (size_t)(r + k - (seq1 - 2)) * D + ch0; *(f32x4*)so = (f32x4){z[0], z[1], z[2], z[3]}; *(f32x4*)(so + 4) = (f32x4){z[4], z[5], z[6], z[7]}; }
        }
    }
    for (; r < r1; ++r) {
        const bf16_t* q = proj + (size_t)lrow(r, rows0) * NA;
        float b[8], c[8], h[8], y[8], z[8];
        unpack8(*(const u32x4*)(q + ch0), b); unpack8(*(const u32x4*)(q + D + ch0), c); unpack8(*(const u32x4*)(q + 2 * D + ch0), h);
#pragma unroll
        for (int i = 0; i < 8; ++i) { z[i] = c[i] * h[i]; y[i] = b[i] * (w0[i] * zm2[i] + w1[i] * zm1[i] + w2[i] * z[i]); zm2[i] = zm1[i]; zm1[i] = z[i]; }
        *(u32x4*)(ycat + (size_t)r * DMIX + ch0) = pack8(y);
        if (r >= seq1 - 2) { float* so = state_out + (size_t)(r - (seq1 - 2)) * D + ch0; *(f32x4*)so = (f32x4){z[0], z[1], z[2], z[3]}; *(f32x4*)(so + 4) = (f32x4){z[4], z[5], z[6], z[7]}; }
    }
}
__device__ __forceinline__ void mixa_phase(const Params& p, const bf16_t* proj, bf16_t* ycat, int chunk, bool has_s) {
    const int lane = otid() & 63, wid = otid() >> 6, half = wid >> 2, ch0 = (wid & 3) * 512 + lane * 8, rows0 = chunk * CH;
    for (int it = blockIdx.x; it < CH / 64; it += gridDim.x) {
        const int r0 = rows0 + it * 64 + half * 32;
        mixa_rows(p, proj, ycat, rows0, r0, r0 + 32, rows0, rows0 + CH, nullptr, p.out + O_CAP + (size_t)chunk * 2 * D, ch0);
    }
    if (has_s && half == 0)
        for (int it = blockIdx.x; it < NSAMP; it += gridDim.x) {
            const int b = it >> 5, row = NPROMPT + it, s0 = NPROMPT + b * 32;
            mixa_rows(p, proj, ycat, rows0, row, row + 1, s0, s0 + 32, p.in[I_CCA] + (size_t)b * 2 * D, p.out + O_CAS + (size_t)b * 2 * D, ch0);
        }
}

template <bool ISK> __device__ __forceinline__ void attn_fill(unsigned char* shm, const bf16_t* src, int gpitch) {
    const int tid = otid();
    u32x4 v[16];
#pragma unroll
    for (int i = 0; i < 16; ++i) { const int idx = tid + 512 * i, r = idx >> 5, c = idx & 31; v[i] = *(const u32x4*)(src + (size_t)r * gpitch + c * 8); }
#pragma unroll
    for (int i = 0; i < 16; ++i) { const int idx = tid + 512 * i, r = idx >> 5, c = idx & 31; const int f = ISK ? ((r & 3) | (((r >> 3) & 3) << 2)) : (r & 15);
        *(u32x4*)(shm + r * 512 + ((c ^ f) << 4)) = v[i]; }
}
__device__ __forceinline__ void attn_block(const bf16_t* qb, int ldp, const bf16_t* Kg, const bf16_t* Vg, bf16_t* ob, int ngroups, unsigned char* shm) {
    const int tid = otid(), lane = tid & 63, wid = tid >> 6, fr = lane & 15, fq = lane >> 4;
    int offs[4];
#pragma unroll
    for (int b2 = 0; b2 < 4; ++b2) offs[b2] = ((b2 ^ (fr >> 2)) << 6) + ((fq ^ (fr & 3)) << 4);
    const int rbk = (8 * (fr >> 2) + (fr & 3)) * 512, rbv = fr * 512;
    __syncthreads();
    attn_fill<true>(shm, Kg, 1024);
    __syncthreads();
    bf16x8 pf[2][8]; float inv[2];
#pragma unroll
    for (int gi = 0; gi < 2; ++gi) {
        const int grp = wid + 8 * gi;
        if (grp < ngroups) {
            const bf16_t* qg = qb + (size_t)(grp * 16 + fr) * ldp + fq * 8;
            bf16x8 q[8];
#pragma unroll
            for (int ks = 0; ks < 8; ++ks) q[ks] = *(const bf16x8*)(qg + ks * 32);
            f32x4 s[16];
#pragma unroll
            for (int nt = 0; nt < 16; ++nt) {
                f32x4 a = (f32x4){0.f, 0.f, 0.f, 0.f};
#pragma unroll
                for (int ks = 0; ks < 8; ++ks) { const bf16x8 kf = *(const bf16x8*)(shm + (nt >> 1) * 16384 + (nt & 1) * 2048 + rbk + (ks >> 2) * 256 + offs[ks & 3]); a = __builtin_amdgcn_mfma_f32_16x16x32_bf16(kf, q[ks], a, 0, 0, 0); }
                s[nt] = a;
            }
            float mx = -3.0e38f;
#pragma unroll
            for (int nt = 0; nt < 16; ++nt) mx = fmaxf(fmaxf(fmaxf(s[nt][0], s[nt][1]), fmaxf(s[nt][2], s[nt][3])), mx);
            mx = fmaxf(mx, __shfl_xor(mx, 16)); mx = fmaxf(mx, __shfl_xor(mx, 32));
            const float sc = 0.0625f * 1.44269504089f; float sum = 0.f;
#pragma unroll
            for (int nt = 0; nt < 16; ++nt)
#pragma unroll
                for (int j = 0; j < 4; ++j) { const float e = __builtin_amdgcn_exp2f((s[nt][j] - mx) * sc); s[nt][j] = e; sum += e; }
            sum += __shfl_xor(sum, 16); sum += __shfl_xor(sum, 32);
            inv[gi] = 1.0f / sum;
#pragma unroll
            for (int ks = 0; ks < 8; ++ks) { u32x4 w; w.x = pk(s[2 * ks][0], s[2 * ks][1]); w.y = pk(s[2 * ks][2], s[2 * ks][3]); w.z = pk(s[2 * ks + 1][0], s[2 * ks + 1][1]); w.w = pk(s[2 * ks + 1][2], s[2 * ks + 1][3]); pf[gi][ks] = __builtin_bit_cast(bf16x8, w); }
        }
    }
    __syncthreads();
    attn_fill<false>(shm, Vg, 256);
    __syncthreads();
#pragma unroll
    for (int gi = 0; gi < 2; ++gi) {
        const int grp = wid + 8 * gi;
        if (grp < ngroups) {
            bf16_t* og = ob + (size_t)(grp * 16 + fr) * DMIX + 4 * fq;
#pragma unroll
            for (int dt = 0; dt < 16; ++dt) {
                f32x4 o = (f32x4){0.f, 0.f, 0.f, 0.f};
#pragma unroll
                for (int ks = 0; ks < 8; ++ks) { const bf16x8 vf = *(const bf16x8*)(shm + dt * 8192 + rbv + (ks >> 2) * 256 + offs[ks & 3]); o = __builtin_amdgcn_mfma_f32_16x16x32_bf16(vf, pf[gi][ks], o, 0, 0, 0); }
                u32x2 w; w.x = pk(o[0] * inv[gi], o[1] * inv[gi]); w.y = pk(o[2] * inv[gi], o[3] * inv[gi]);
                *(u32x2*)(og + dt * 16) = w;
            }
        }
    }
}
__device__ __forceinline__ void attn_phase(const Params& p, int layer, int chunk, bool has_s, const bf16_t* proj, int ldp, bf16_t* ycat, unsigned char* shm) {
    const int rows0 = chunk * CH;
    const bf16_t* Kb = (const bf16_t*)(p.ws + WS_KB); const bf16_t* Vt = (const bf16_t*)(p.ws + WS_VT);
    const int np = (CH / 256) * 4, nit = np + (has_s ? 32 : 0);
    for (int it = blockIdx.x; it < nit; it += gridDim.x) {
        int hd, t0, bb, ng;
        if (it < np) { hd = it & 3; t0 = rows0 + (it >> 2) * 256; bb = 8 + chunk; ng = 16; }
        else { const int i2 = it - np; hd = i2 & 3; bb = i2 >> 2; t0 = NPROMPT + bb * 32; ng = 2; }
        const int bbi = layer * 10 + bb; const size_t lr = (size_t)lrow(t0, rows0);
        attn_block(proj + lr * ldp + (ldp - 1024) + hd * 256, ldp, Kb + (size_t)bbi * 262144 + hd * 256, Vt + ((size_t)bbi * 4 + hd) * 65536, ycat + (size_t)t0 * DMIX + D + hd * 256, ng, shm);
    }
    __syncthreads();
}

__device__ __forceinline__ void stats_phase(const Params& p, const bf16_t* proj, int chunk, bool has_s) {
    const int lane = otid() & 63, wid = otid() >> 6, rows0 = chunk * CH;
    float* stats = (float*)(p.ws + WS_STATS);
    const int nr = CH + (has_s ? NSAMP : 0);
    for (int i = blockIdx.x * 8 + wid; i < nr; i += gridDim.x * 8) {
        const int row = i < CH ? rows0 + i : NPROMPT + (i - CH);
        const bf16_t* q = proj + (size_t)lrow(row, rows0) * NB + D;
        float v[32]; float s = 0.f;
#pragma unroll
        for (int k = 0; k < 4; ++k) { float f[8]; unpack8(*(const u32x4*)(q + (k * 64 + lane) * 8), f);
#pragma unroll
            for (int j = 0; j < 8; ++j) { v[k * 8 + j] = f[j]; s += f[j]; } }
#pragma unroll
        for (int o = 32; o >= 1; o >>= 1) s += __shfl_xor(s, o);
        const float mean = s * (1.0f / 2048.0f); float qq = 0.f;
#pragma unroll
        for (int j = 0; j < 32; ++j) { const float d = v[j] - mean; qq += d * d; }
#pragma unroll
        for (int o = 32; o >= 1; o >>= 1) qq += __shfl_xor(qq, o);
        if (lane == 0) { stats[(size_t)row * 2] = mean; stats[(size_t)row * 2 + 1] = rsqrtf(qq * (1.0f / 2048.0f) + EPS); }
    }
}
constexpr int VS = 136;
__device__ __forceinline__ void gmlp_item(const Params& p, const bf16_t* proj, bf16_t* ycat, int rows0, int row0, int nrows, int g, int sb, unsigned char* shm) {
    const int tid = otid(), lane = tid & 63, wid = tid >> 6, fr = lane & 15, fq = lane >> 4;
    bf16_t* vT = (bf16_t*)shm;
    const float* stats = (const float*)(p.ws + WS_STATS);
    {
        const int d0 = (tid & 31) * 8, c0 = g * 256 + d0;
        float gam[8], bet[8];
#pragma unroll
        for (int j = 0; j < 8; ++j) { gam[j] = p.in[I_GNG][c0 + j]; bet[j] = p.in[I_GNB][c0 + j]; }
#pragma unroll 2
        for (int i = 0; i < 8; ++i) {
            const int s = (tid >> 5) + 16 * i;
            float vn[8];
            if (s < nrows) {
                const int r = row0 + s;
                float f[8]; unpack8(*(const u32x4*)(proj + (size_t)lrow(r, rows0) * NB + D + c0), f);
                const float mean = stats[(size_t)r * 2], rstd = stats[(size_t)r * 2 + 1];
#pragma unroll
                for (int j = 0; j < 8; ++j) vn[j] = (f[j] - mean) * rstd * gam[j] + bet[j];
                if (sb >= 0) { float* o = p.out + O_GVS + ((size_t)(sb * 32 + s)) * D + c0; *(f32x4*)o = (f32x4){vn[0], vn[1], vn[2], vn[3]}; *(f32x4*)(o + 4) = (f32x4){vn[4], vn[5], vn[6], vn[7]}; }
            } else {
#pragma unroll
                for (int j = 0; j < 8; ++j) vn[j] = 0.f;
            }
#pragma unroll
            for (int j = 0; j < 4; ++j) { const unsigned w = pk(vn[2 * j], vn[2 * j + 1]); const int sx = s ^ (((tid & 31) & 15) << 3);
                vT[(d0 + 2 * j) * VS + sx] = (bf16_t)(w & 0xffffu); vT[(d0 + 2 * j + 1) * VS + sx] = (bf16_t)(w >> 16); }
        }
    }
    __syncthreads();
    const bf16_t* Wm = (const bf16_t*)(p.ws + WS_WM) + (size_t)g * 16384;
    const int ntt = nrows >> 4, dbase = wid * 32;
    f32x4 acc[2][8];
#pragma unroll
    for (int dt = 0; dt < 2; ++dt)
#pragma unroll
        for (int tt = 0; tt < 8; ++tt) acc[dt][tt] = (f32x4){0.f, 0.f, 0.f, 0.f};
#pragma unroll
    for (int ks = 0; ks < 4; ++ks) {
        if (ks * 32 < nrows) {
            bf16x8 af[2];
#pragma unroll
            for (int dt = 0; dt < 2; ++dt) { const int d = dbase + dt * 16 + fr; af[dt] = *(const bf16x8*)(vT + d * VS + ((ks * 32 + fq * 8) ^ (((d >> 3) & 15) << 3))); }
#pragma unroll
            for (int tt = 0; tt < 8; ++tt) {
                if (tt < ntt && ks * 32 <= tt * 16 + 15) {
                    const bf16x8 bw = *(const bf16x8*)(Wm + (size_t)(tt * 16 + fr) * 128 + ks * 32 + fq * 8);
#pragma unroll
                    for (int dt = 0; dt < 2; ++dt) acc[dt][tt] = __builtin_amdgcn_mfma_f32_16x16x32_bf16(af[dt], bw, acc[dt][tt], 0, 0, 0);
                }
            }
        }
    }
    const float* gb = p.in[I_GBIAS] + g * 128;
#pragma unroll
    for (int tt = 0; tt < 8; ++tt) {
        if (tt < ntt) {
            const int t = tt * 16 + fr; const size_t lr = (size_t)lrow(row0 + t, rows0);
            const float bias = gb[t];
#pragma unroll
            for (int dt = 0; dt < 2; ++dt) {
                const int dc = g * 256 + dbase + dt * 16 + 4 * fq;
                const u32x2 uu = *(const u32x2*)(proj + lr * NB + dc);
                const f32x4 a = acc[dt][tt];
                u32x2 w; w.x = pk(bf_lo(uu.x) * (a[0] + bias), bf_hi(uu.x) * (a[1] + bias)); w.y = pk(bf_lo(uu.y) * (a[2] + bias), bf_hi(uu.y) * (a[3] + bias));
                *(u32x2*)(ycat + (size_t)(row0 + t) * DMIX + dc) = w;
            }
        }
    }
    __syncthreads();
}
__device__ __forceinline__ void gmlp_phase(const Params& p, const bf16_t* proj, bf16_t* ycat, int chunk, bool has_s, unsigned char* shm) {
    const int rows0 = chunk * CH;
    const int nit = (CH / 128) * 8 + (has_s ? 64 : 0);
    for (int it = blockIdx.x; it < nit; it += gridDim.x) {
        if (it < (CH / 128) * 8) gmlp_item(p, proj, ycat, rows0, rows0 + (it >> 3) * 128, 128, it & 7, -1, shm);
        else { const int i2 = it - (CH / 128) * 8, b = i2 >> 3; gmlp_item(p, proj, ycat, rows0, NPROMPT + b * 32, 32, i2 & 7, b, shm); }
    }
}

__device__ __forceinline__ void ffn_rows(const Params& p, int layer, const bf16_t* z, bf16_t* h, int rows0, int r0, int r1, int seq0, int seq1, const float* prev, float* state_out, int c0) {
    const float* cw = p.in[I_FCW] + (size_t)layer * 3 * DFF2; const float* cb = p.in[I_FCB] + (size_t)layer * DFF2;
    float wa[3][8], wg[3][8], ba[8], bg[8], am2[8], am1[8], gm2[8], gm1[8];
    const int za_off = (c0 >> 7) * 256 + (c0 & 127), zg_off = za_off + 128;
#pragma unroll
    for (int k = 0; k < 3; ++k)
#pragma unroll
        for (int i = 0; i < 8; ++i) { wa[k][i] = cw[k * DFF2 + c0 + i]; wg[k][i] = cw[k * DFF2 + DFF + c0 + i]; }
#pragma unroll
    for (int i = 0; i < 8; ++i) { ba[i] = cb[c0 + i]; bg[i] = cb[DFF + c0 + i]; }
    {
        const int ra = r0 - 2, rb = r0 - 1;
        if (ra >= seq0) { const bf16_t* q = z + (size_t)lrow(ra, rows0) * DFF2; unpack8(*(const u32x4*)(q + za_off), am2); unpack8(*(const u32x4*)(q + zg_off), gm2); }
        else {
#pragma unroll
            for (int i = 0; i < 8; ++i) { am2[i] = prev ? prev[(size_t)(ra - seq0 + 2) * DFF2 + c0 + i] : 0.f; gm2[i] = prev ? prev[(size_t)(ra - seq0 + 2) * DFF2 + DFF + c0 + i] : 0.f; } }
        if (rb >= seq0) { const bf16_t* q = z + (size_t)lrow(rb, rows0) * DFF2; unpack8(*(const u32x4*)(q + za_off), am1); unpack8(*(const u32x4*)(q + zg_off), gm1); }
        else {
#pragma unroll
            for (int i = 0; i < 8; ++i) { am1[i] = prev ? prev[(size_t)(rb - seq0 + 2) * DFF2 + c0 + i] : 0.f; gm1[i] = prev ? prev[(size_t)(rb - seq0 + 2) * DFF2 + DFF + c0 + i] : 0.f; } }
    }
#pragma unroll 4
    for (int r = r0; r < r1; ++r) {
        const bf16_t* q = z + (size_t)lrow(r, rows0) * DFF2;
        float a[8], g[8], o[8];
        unpack8(*(const u32x4*)(q + za_off), a); unpack8(*(const u32x4*)(q + zg_off), g);
#pragma unroll
        for (int i = 0; i < 8; ++i) {
            const float ca = wa[0][i] * am2[i] + wa[1][i] * am1[i] + wa[2][i] * a[i] + ba[i];
            const float cg = wg[0][i] * gm2[i] + wg[1][i] * gm1[i] + wg[2][i] * g[i] + bg[i];
            o[i] = ca * cg * __builtin_amdgcn_rcpf(1.0f + __builtin_amdgcn_exp2f(-1.44269504089f * cg));
            am2[i] = am1[i]; am1[i] = a[i]; gm2[i] = gm1[i]; gm1[i] = g[i];
        }
        *(u32x4*)(h + (size_t)r * DFF + c0) = pack8(o);
        if (r >= seq1 - 2) { float* so = state_out + (size_t)(r - (seq1 - 2)) * DFF2 + c0;
            *(f32x4*)so = (f32x4){a[0], a[1], a[2], a[3]}; *(f32x4*)(so + 4) = (f32x4){a[4], a[5], a[6], a[7]};
            *(f32x4*)(so + DFF) = (f32x4){g[0], g[1], g[2], g[3]}; *(f32x4*)(so + DFF + 4) = (f32x4){g[4], g[5], g[6], g[7]}; }
    }
}
__device__ __forceinline__ void ffn_mid_phase(const Params& p, int layer, const bf16_t* z, bf16_t* h, int chunk, bool has_s) {
    const int tid = otid(), lane = tid & 63, wid = tid >> 6, rows0 = chunk * CH;
    if (!has_s) return;
    const int nw = gridDim.x * 8;
    for (int i2 = nw - 1 - (int)(blockIdx.x * 8 + wid); i2 < 8 * 8 * 11; i2 += nw) {
        const int cbk = i2 % 11, rb = i2 / 11, b = rb >> 3, s0 = NPROMPT + b * 32, r0 = s0 + (rb & 7) * 4;
        ffn_rows(p, layer, z, h, rows0, r0, r0 + 4, s0, s0 + 32, p.in[I_CFC] + (size_t)((layer * 8 + b) * 2) * DFF2, p.out + O_FCS + (size_t)((layer * 8 + b) * 2) * DFF2, (cbk * 64 + lane) * 8);
    }
}
__device__ __forceinline__ void ffn_fix_phase(const Params& p, int layer, const float* halo, bf16_t* h) {
    const int tid = otid(), lane = tid & 63, wid = tid >> 6;
    const float* cw = p.in[I_FCW] + (size_t)layer * 3 * DFF2; const float* cb = p.in[I_FCB] + (size_t)layer * DFF2;
    for (int it = blockIdx.x * 8 + wid; it < (NPROMPT / 64) * 11; it += gridDim.x * 8) {
        const int blk = it / 11, c0 = ((it % 11) * 64 + lane) * 8, bseq = blk & (CH / 64 - 1), chunk = blk / (CH / 64);
        float o0[8], o1[8];
#pragma unroll
        for (int part = 0; part < 2; ++part) {
            const int cc = part * DFF + c0;
            float w0[8], w1[8], w2[8], bb[8], z0[8], z1[8], zm1[8], zm2[8];
#pragma unroll
            for (int i = 0; i < 8; ++i) { w0[i] = cw[cc + i]; w1[i] = cw[DFF2 + cc + i]; w2[i] = cw[2 * DFF2 + cc + i]; bb[i] = cb[cc + i]; }
            const float* hp = halo + (size_t)blk * 4 * DFF2 + cc;
#pragma unroll
            for (int i = 0; i < 8; ++i) { z0[i] = hp[i]; z1[i] = hp[DFF2 + i]; zm2[i] = bseq > 0 ? hp[i - 2 * DFF2] : 0.f; zm1[i] = bseq > 0 ? hp[i - DFF2] : 0.f; }
#pragma unroll
            for (int i = 0; i < 8; ++i) {
                const float c_0 = w0[i] * zm2[i] + w1[i] * zm1[i] + w2[i] * z0[i] + bb[i];
                const float c_1 = w0[i] * zm1[i] + w1[i] * z0[i] + w2[i] * z1[i] + bb[i];
                if (part == 0) { o0[i] = c_0; o1[i] = c_1; }
                else { o0[i] = o0[i] * c_0 * __builtin_amdgcn_rcpf(1.0f + __builtin_amdgcn_exp2f(-1.44269504089f * c_0)); o1[i] = o1[i] * c_1 * __builtin_amdgcn_rcpf(1.0f + __builtin_amdgcn_exp2f(-1.44269504089f * c_1)); }
            }
            if (bseq == CH / 64 - 1) {
                float* so = p.out + O_FCP + (size_t)((layer * 2 + chunk) * 2) * DFF2 + cc;
#pragma unroll
                for (int i = 0; i < 8; ++i) { so[i] = hp[2 * DFF2 + i]; so[DFF2 + i] = hp[3 * DFF2 + i]; }
            }
        }
        *(u32x4*)(h + (size_t)(blk * 64) * DFF + c0) = pack8(o0);
        *(u32x4*)(h + (size_t)(blk * 64 + 1) * DFF + c0) = pack8(o1);
    }
}

__device__ __forceinline__ void final_phase(const Params& p) {
    const int tid = otid(), lane = tid & 63, wid = tid >> 6;
    const float* ss = (const float*)(p.ws + WS_SS); const float* gf = p.in[I_GFIN]; const bf16_t* xb = (const bf16_t*)(p.ws + WS_XB);
    for (int row = blockIdx.x * 8 + wid; row < NROWS; row += gridDim.x * 8) {
        float s = lane < 32 ? ss[(size_t)row * 32 + lane] : 0.f;
#pragma unroll
        for (int o = 32; o >= 1; o >>= 1) s += __shfl_xor(s, o);
        const float rs = rsqrtf(s * (1.0f / 2048.0f) + EPS);
        const bf16_t* x = xb + (size_t)row * D; float* y = p.out + (size_t)row * D;
#pragma unroll
        for (int k = 0; k < 4; ++k) { const int c = (k * 64 + lane) * 8; float f[8]; unpack8(*(const u32x4*)(x + c), f);
            const f32x4 g0 = *(const f32x4*)(gf + c), g1 = *(const f32x4*)(gf + c + 4);
            *(f32x4*)(y + c) = (f32x4){f[0], f[1], f[2], f[3]} * rs * g0; *(f32x4*)(y + c + 4) = (f32x4){f[4], f[5], f[6], f[7]} * rs * g1; }
    }
}

__global__ void __launch_bounds__(512, 2) fwd_kernel(Params p) {
    extern __shared__ __attribute__((aligned(16))) unsigned char shm[];
    cg::grid_group grid = cg::this_grid();
    LAS unsigned char* lds0 = (LAS unsigned char*)shm;
    {
        volatile LAS unsigned* st = (volatile LAS unsigned*)(lds0 + pg8::STAGE_BYTES);
        if (threadIdx.x < 2) st[threadIdx.x] = 0u;
        __syncthreads();
    }
    const XcdBarrier xbar = xcd_barrier_post((unsigned*)(p.ws + WS_BAR), (volatile LAS unsigned*)(lds0 + pg8::STAGE_BYTES));
#define GSYNC() do { for (int rep_ = 0; rep_ < REP_SYNC; ++rep_) xcd_barrier(xbar); } while (0)
    PG8_LAS unsigned char* lds = (PG8_LAS unsigned char*)shm;
    unsigned char* ws = p.ws;
    const int G = gridDim.x, bid = blockIdx.x;
    bf16_t* xb = (bf16_t*)(ws + WS_XB); float* ss = (float*)(ws + WS_SS);
    bf16_t* proj = (bf16_t*)(ws + WS_BIG + BIG_PROJ); bf16_t* ycat = (bf16_t*)(ws + WS_BIG + BIG_YCAT);
    bf16_t* hb = (bf16_t*)(ws + WS_BIG + BIG_H); float* halo = (float*)(ws + WS_BIG + BIG_HALO);
    bf16_t* zb = (bf16_t*)(ws + WS_BIG + BIG_ZS) - (size_t)CH * DFF2;

    for (int rep = 0; rep < REP_PREP; ++rep) prep_phase(p, shm);
    if (p.ws == nullptr) grid.sync();
    GSYNC();

#pragma unroll 1
    for (int layer = 0; layer < 2; ++layer) {
#pragma unroll 1
        for (int chunk = 0; chunk < 2; ++chunk) {
            const int rows0 = chunk * CH; const bool has_s = chunk == 0;
            {
                const int N1 = layer ? NB : NA; const bf16_t* W1 = (const bf16_t*)(ws + (layer ? WS_WINB : WS_WINA));
                const OpScale op{ss, proj, N1, rows0, layer ? 2 * D : 0};
                pg8::Gemm g{xb + (size_t)rows0 * D, W1, CH, N1, D}; pg8::StaticOrder S; S.init(CH, N1, G, bid);
                EpiG<OpScale> E{op, rows0};
                pg8::gemm_phase<EpiG<OpScale>, pg8::StaticOrder, GEMM_ALIGN, GEMM_SP2>(lds, g, S, E);
                if (has_s) small_gemm(xb + (size_t)NPROMPT * D, D, W1, NSAMP, N1, D, op, NPROMPT, shm);
                if (chunk == 0 && layer == 0) {
                    const OpMemKV om{(const float*)(ws + WS_SSM), p.out + O_MKP, p.out + O_MVP, (bf16_t*)(ws + WS_KB), (bf16_t*)(ws + WS_VT)};
                    small_gemm((const bf16_t*)(ws + WS_MEMB), D, (const bf16_t*)(ws + WS_WMEM), 512, 4096, D, om, 0, shm);
                }
            }
            GSYNC();
            if (layer == 0) {
                mixa_phase(p, proj, ycat, chunk, has_s);
                attn_phase(p, 0, chunk, has_s, proj, NA, ycat, shm);
            }
            else {
                stats_phase(p, proj, chunk, has_s);
                GSYNC();
                gmlp_phase(p, proj, ycat, chunk, has_s, shm);
                attn_phase(p, 1, chunk, has_s, proj, NB, ycat, shm);
            }
            GSYNC();
        }
        {
            const bf16_t* W = (const bf16_t*)(ws + WS_WOUT) + (size_t)layer * D * DMIX;
            const OpResid opp{xb, ss};
            const OpResid ops{xb, ss};
            pg8::Gemm g{ycat, W, NPROMPT, D, DMIX}; pg8::StaticOrder S; S.init(NPROMPT, D, G, bid);
            EpiG<OpResid> E{opp, 0};
            pg8::gemm_phase<EpiG<OpResid>, pg8::StaticOrder, GEMM_ALIGN, GEMM_SP2>(lds, g, S, E);
            small_gemm(ycat + (size_t)NPROMPT * DMIX, DMIX, W, NSAMP, D, DMIX, ops, NPROMPT, shm);
        }
        GSYNC();
        {
            const bf16_t* W = (const bf16_t*)(ws + WS_WUP) + (size_t)layer * D * DFF2;
            const OpScale op{ss, zb, DFF2, 0, 0};
            pg8::Gemm g{xb, W, NPROMPT, DFF2, D}; pg8::StaticOrder S; S.init(NPROMPT, DFF2, G, bid);
            const EpiFfn E{ss, p.in[I_FCW] + (size_t)layer * 3 * DFF2, p.in[I_FCB] + (size_t)layer * DFF2, hb, halo, 0};
            pg8::gemm_phase<EpiFfn, pg8::StaticOrder, GEMM_ALIGN, GEMM_SP2>(lds, g, S, E);
            small_gemm(xb + (size_t)NPROMPT * D, D, W, NSAMP, DFF2, D, op, NPROMPT, shm);
        }
        GSYNC();
        ffn_fix_phase(p, layer, halo, hb);
        ffn_mid_phase(p, layer, zb, hb, 0, true);
        GSYNC();
        {
            const bf16_t* W = (const bf16_t*)(ws + WS_WDOWN) + (size_t)layer * D * DFF;
            const OpResid op{xb, ss};
            pg8::Gemm g{hb, W, NPROMPT, D, DFF}; pg8::StaticOrder S; S.init(NPROMPT, D, G, bid);
            EpiG<OpResid> E{op, 0};
            pg8::gemm_phase<EpiG<OpResid>, pg8::StaticOrder, GEMM_ALIGN, GEMM_SP2>(lds, g, S, E);
            small_gemm(hb + (size_t)NPROMPT * DFF, DFF, W, NSAMP, D, DFF, op, NPROMPT, shm);
        }
        GSYNC();
    }
    final_phase(p);
}

extern "C" void kernel_launch(void* const* d_in, const int* in_sizes, int n_in, void* d_out, int out_size, void* d_ws, size_t ws_size, hipStream_t stream) {
    static int grid = 0;
    if (grid == 0) {
        if (n_in != 25 || ws_size < WS_END) { fprintf(stderr, "kernel_launch: unexpected shapes: n_in %d ws %zu (need %zu)\n", n_in, ws_size, (size_t)WS_END); grid = -1; return; }
        int dev = 0, cus = 0, per_cu = 0;
        hipGetDevice(&dev);
        hipDeviceGetAttribute(&cus, hipDeviceAttributeMultiprocessorCount, dev);
        if (hipFuncSetAttribute((const void*)fwd_kernel, hipFuncAttributeMaxDynamicSharedMemorySize, LDS_BYTES) != hipSuccess) { fprintf(stderr, "kernel_launch: hipFuncSetAttribute failed\n"); }
        if (hipOccupancyMaxActiveBlocksPerMultiprocessor(&per_cu, (const void*)fwd_kernel, 512, LDS_BYTES) != hipSuccess || per_cu < 1) { fprintf(stderr, "kernel_launch: occupancy query says %d\n", per_cu); per_cu = 1; }
        (void)hipGetLastError();
        grid = cus;
    }
    if (grid < 0) return;
    if (hipMemsetAsync((char*)d_ws + WS_BAR, 0, 16384, stream) != hipSuccess) { fprintf(stderr, "kernel_launch: memset of the barrier words failed\n"); return; }
    Params p{};
    for (int i = 0; i < 25; ++i) p.in[i] = (const float*)d_in[i];
    p.out = (float*)d_out; p.ws = (unsigned char*)d_ws;
    void* args[] = {&p};
    hipError_t e = hipLaunchCooperativeKernel((const void*)fwd_kernel, dim3(grid), dim3(512), args, LDS_BYTES, stream);
    if (e != hipSuccess) fprintf(stderr, "kernel_launch: cooperative launch failed: %s (grid %d)\n", hipGetErrorString(e), grid);
}
```

```cpp
#include <hip/hip_runtime.h>
#include <hip/hip_cooperative_groups.h>
#include <cstdio>
namespace cg = cooperative_groups;
#define REP_ATTN 1
#define REP_ELEM 1
#define REP_PREP 1
#define REP_GEMM 1
#define REP_SMALL 1
#define REP_SYNC 1
#define GEMM_ALIGN true
#define GEMM_SP2 true
#define STAGGER 1

#define XB_TMO      128
#define XB_XCNT(j)  (256  + 64 * (j))
#define XB_XSUB(j)  (1280 + 64 * (j))
#define XB_XGEN(j)  (2304 + 64 * (j))
#define XB_TOP      3328
#define XB_TOPGEN   3392
#define XCD_BAR_WORDS 3456
#define XB_SPIN_CAP (1u << 18)
#define LAS __attribute__((address_space(3)))

__device__ __forceinline__ unsigned xb_ld(unsigned* p)              { return __hip_atomic_load(p, __ATOMIC_RELAXED, __HIP_MEMORY_SCOPE_AGENT); }
__device__ __forceinline__ unsigned xb_add(unsigned* p, unsigned v) { return __hip_atomic_fetch_add(p, v, __ATOMIC_RELAXED, __HIP_MEMORY_SCOPE_AGENT); }
__device__ __forceinline__ unsigned xb_xcc_id() { return (unsigned)__builtin_amdgcn_s_getreg((3 << 11) | 20) & 0xFu; }
#define XB_SPIN(cond, bar) do { unsigned _sp = 0; while (cond) { __builtin_amdgcn_s_sleep(1); \
    if ((++_sp & 255u) == 0u) { if (xb_ld(&(bar)[XB_TMO])) break; if (_sp > XB_SPIN_CAP) { atomicAdd(&(bar)[XB_TMO], 1u); break; } } } } while (0)

struct XcdBarrier {
    unsigned* bar; unsigned x;
    volatile LAS unsigned* st;
};

__device__ __forceinline__ XcdBarrier xcd_barrier_post(unsigned* bar, volatile LAS unsigned* st) {
    XcdBarrier b; b.bar = bar; b.x = xb_xcc_id(); b.st = st;
    if (threadIdx.x == 0) (void)xb_add(&bar[XB_XCNT(b.x)], 1u);
    return b;
}
__device__ __forceinline__ void xcd_barrier_complete(unsigned* bar, unsigned x, unsigned& nloc, unsigned& nx) {
    const unsigned G = gridDim.x * gridDim.y * gridDim.z;
    unsigned sum, cnt, mine, sp = 0u;
    for (;;) {
        sum = 0u; cnt = 0u; mine = 0u;
#pragma unroll
        for (unsigned j = 0; j < 16; ++j) { const unsigned c = xb_ld(&bar[XB_XCNT(j)]); sum += c; cnt += (c > 0u) ? 1u : 0u; mine = (j == x) ? c : mine; }
        if (sum == G) break;
        __builtin_amdgcn_s_sleep(1);
        if ((++sp & 255u) == 0u) { if (xb_ld(&bar[XB_TMO])) break; if (sp > XB_SPIN_CAP) { atomicAdd(&bar[XB_TMO], 1u); break; } }
    }
    nloc = mine > 0u ? mine : 1u; nx = cnt > 0u ? cnt : 1u;
}

__device__ __forceinline__ void xcd_barrier(const XcdBarrier& b) {
    asm volatile("s_waitcnt vmcnt(0)" ::: "memory");
    __syncthreads();
    if (threadIdx.x == 0) {
        unsigned* bar = b.bar;
        __builtin_amdgcn_s_waitcnt(0);
        unsigned nloc = b.st[0], nx = b.st[1];
        if (nloc == 0u) { xcd_barrier_complete(bar, b.x, nloc, nx); b.st[0] = nloc; b.st[1] = nx; }
        const unsigned old = xb_add(&bar[XB_XSUB(b.x)], 1u);
        const unsigned gen = old / nloc;
        if (old + 1u == (gen + 1u) * nloc) {
            __builtin_amdgcn_fence(__ATOMIC_RELEASE, "agent");
            asm volatile("s_waitcnt vmcnt(0)" ::: "memory");
            const unsigned og = xb_add(&bar[XB_TOP], 1u);
            const unsigned tg = og / nx;
            if (og + 1u == (tg + 1u) * nx) xb_add(&bar[XB_TOPGEN], 1u);
            else XB_SPIN(xb_ld(&bar[XB_TOPGEN]) == tg, bar);
            __builtin_amdgcn_fence(__ATOMIC_ACQUIRE, "agent");
            xb_add(&bar[XB_XGEN(b.x)], 1u);
            asm volatile("s_waitcnt vmcnt(0)" ::: "memory");
        } else {
            XB_SPIN(xb_ld(&bar[XB_XGEN(b.x)]) == gen, bar);
            __builtin_amdgcn_fence(__ATOMIC_ACQUIRE, "agent");
            asm volatile("s_waitcnt vmcnt(0)" ::: "memory");
        }
    }
    __syncthreads();
}
namespace pg8 {
#define PG8_LAS __attribute__((address_space(3)))
typedef unsigned short bf16_t;
}
__device__ __forceinline__ int otid() { int t = threadIdx.x; asm volatile("" : "+v"(t)); return t; }
namespace pg8 {
typedef short bf16x8 __attribute__((ext_vector_type(8)));
typedef float f32x4 __attribute__((ext_vector_type(4)));
typedef unsigned u32x4 __attribute__((ext_vector_type(4)));
constexpr int BM = 256, BK = 64, HALF = 128, HTB = HALF * BK * 2  , STAGE_BYTES = 8 * HTB, NXCD = 8, WGM = 4;

__host__ __device__ __forceinline__ int lds_byte(int r, int c) { const int st = (r >> 4) * 2 + (c >> 5), rr = r & 15, cc = c & 31, ob = rr * 64 + cc * 2; return st * 1024 + (ob ^ (((ob >> 9) & 1) << 5)); }
__host__ __device__ __forceinline__ void stage_rc(int b, int& R, int& C) { const int st = b / 1024, sb = b % 1024, swz = sb ^ (((sb >> 9) & 1) << 5); R = (st >> 1) * 16 + swz / 64; C = (st & 1) * 32 + (swz % 64) / 2; }
__host__ __device__ __forceinline__ int perm32(int rho) { const int n = rho >> 4, i = rho & 15; return 8 * (i >> 2) + 4 * n + (i & 3); }

struct Unit { int pm, pn; };
struct Gemm { const bf16_t* A; const bf16_t* Bt; int M, N, K; };

struct StaticOrder {
    int nM, nN, nwg, G, c;
    __host__ __device__ void init(int M, int N, int G_, int c_) { nM = M / BM; nN = N / BM; nwg = nM * nN; G = G_; c = c_; }
    __host__ __device__ bool next(int i, Unit& u) const {
        const long L = (long)i * G + c; if (L >= nwg) return false;
        int wgid = (int)L; { const int q = nwg / NXCD, r = nwg % NXCD, xcd = wgid % NXCD, off = wgid / NXCD; wgid = (xcd < r ? xcd * (q + 1) : r * (q + 1) + (xcd - r) * q) + off; }
        const int nig = WGM * nN, gid = wgid / nig, fm = gid * WGM, gsz = (nM - fm) < WGM ? (nM - fm) : WGM;
        u.pm = fm + ((wgid % nig) % gsz); u.pn = (wgid % nig) / gsz; return true;
    }
    __device__ __forceinline__ void a_ready(const Unit&) const {}
    __device__ __forceinline__ void done(const Unit&) const {}
};
__device__ __forceinline__ unsigned cvt_pk_bf16(float lo, float hi) { unsigned r; asm volatile("v_cvt_pk_bf16_f32 %0, %1, %2" : "=v"(r) : "v"(lo), "v"(hi)); return r; }
typedef float f32x2 __attribute__((ext_vector_type(2)));
__device__ __forceinline__ f32x2 gelu_pk(f32x2 v) {
    const f32x2 av = __builtin_elementwise_abs(v), d = av * 0.2316418882f + 1.0f;
    f32x2 t; t.x = __builtin_amdgcn_rcpf(d.x); t.y = __builtin_amdgcn_rcpf(d.y);
    f32x2 q = t * 0.5307027145f + (-0.7265760135f); q = q * t + 0.7107068705f; q = q * t + (-0.142248368f); q = q * t + 0.127414796f; q = q * t;
    const f32x2 s = (v * v) * (-0.72134752044f);
    f32x2 e; e.x = __builtin_amdgcn_exp2f(s.x); e.y = __builtin_amdgcn_exp2f(s.y);
    const f32x2 m = v * (q * e), r = v - m;
    f32x2 o; o.x = v.x < 0.f ? m.x : r.x; o.y = v.y < 0.f ? m.y : r.y; return o;
}
template <class Epi, class Sched, bool ALIGN_EPI = false, bool SP2 = false>
__device__ __forceinline__ void gemm_phase(PG8_LAS unsigned char* lds, const Gemm g, const Sched& S, const Epi& E) {
    const int tid = otid(), wid = __builtin_amdgcn_readfirstlane(tid >> 6), lane = tid & 63, wr = wid >> 2, wc = wid & 3, fr = lane & 15, fq = lane >> 4;
    const int K = g.K, nt = K / BK;
    unsigned voffA[2], voffB[2];
#pragma unroll
    for (int i = 0; i < 2; ++i) { int R, C; stage_rc(tid * 16 + i * 8192, R, C); const int Rb = Epi::PERM ? ((R & ~31) + perm32(R & 31)) : R;
        const int Ra = Epi::APERM ? ((R & ~63) + 4 * (R & 15) + ((R >> 4) & 3)) : R;
        voffA[i] = (unsigned)(Ra * K + C) * 2u; voffB[i] = (unsigned)(Rb * K + C) * 2u; }
    const size_t kstep = (size_t)(BK * 2);
    const size_t hstep = (size_t)HALF * K * 2;
    const size_t tstep = 2 * hstep;
    const unsigned ldsw = (unsigned)wid * 1024u;
    const int aoff = lds_byte(wr * 64 + fr, fq * 8), boff = lds_byte(wc * 32 + fr, fq * 8);
#define PG8_SA(b, h) (((b) * 2 + (h)) * HTB)
#define PG8_SB(b, h) ((4 + (b) * 2 + (h)) * HTB)
#define PG8_STAGE(bufoff, gbase, voff) do { _Pragma("unroll") for (int _i = 0; _i < 2; ++_i) \
        __builtin_amdgcn_global_load_lds((const unsigned*)((const char*)(gbase) + (voff)[_i]), (PG8_LAS unsigned*)(lds + (bufoff) + ldsw + _i * 8192), 16, 0, 0); } while (0)
#define PG8_LDA(dst, b, h) do { _Pragma("unroll") for (int m = 0; m < 4; ++m) _Pragma("unroll") for (int k = 0; k < 2; ++k) dst[m][k] = *(const PG8_LAS bf16x8*)(lds + PG8_SA(b, h) + aoff + m * 2048 + k * 1024); } while (0)
#define PG8_LDB(dst, b, h) do { _Pragma("unroll") for (int n = 0; n < 2; ++n) _Pragma("unroll") for (int k = 0; k < 2; ++k) dst[n][k] = *(const PG8_LAS bf16x8*)(lds + PG8_SB(b, h) + boff + n * 2048 + k * 1024); } while (0)
#define PG8_MMA(ai, bj, At, Bt) do { __builtin_amdgcn_s_setprio(1); _Pragma("unroll") for (int m = 0; m < 4; ++m) _Pragma("unroll") for (int n = 0; n < 2; ++n) _Pragma("unroll") for (int k = 0; k < 2; ++k) \
        acc[ai][bj][m][n] = __builtin_amdgcn_mfma_f32_16x16x32_bf16(Bt[n][k], At[m][k], acc[ai][bj][m][n], 0, 0, 0); __builtin_amdgcn_s_setprio(0); } while (0)
#define PG8_WAIT_V(n) asm volatile("s_waitcnt vmcnt(" #n ")" ::: "memory")
#define PG8_WAIT_L(n) asm volatile("s_waitcnt lgkmcnt(" #n ")" ::: "memory")
#define PG8_BAR __builtin_amdgcn_s_barrier()
#define PG8_SCHED __builtin_amdgcn_sched_barrier(0)
    Unit cur, nxt; int ui = 0;
    if (!S.next(0, cur)) return;
    typename Epi::State est; E.init_state(est, cur, lds, tid);
    f32x4 acc[2][2][4][2];
#pragma unroll
    for (int a = 0; a < 2; ++a)
#pragma unroll
        for (int b = 0; b < 2; ++b)
#pragma unroll
            for (int m = 0; m < 4; ++m)
#pragma unroll
                for (int n = 0; n < 2; ++n) acc[a][b][m][n] = (f32x4){0.f, 0.f, 0.f, 0.f};
    if constexpr (Epi::ACC_INIT) E.init_acc(acc, cur, wr, wc, fr, fq);
    bf16x8 At[4][2], B0[2][2], B1[2][2];
    const char* cA = (const char*)g.A + (size_t)cur.pm * tstep; const char* cB = (const char*)g.Bt + (size_t)cur.pn * tstep;
    S.a_ready(cur);
    if constexpr (SP2) {
        PG8_STAGE(PG8_SB(0, 0), cB, voffB); PG8_STAGE(PG8_SB(0, 1), cB + hstep, voffB); PG8_STAGE(PG8_SA(0, 0), cA, voffA); PG8_STAGE(PG8_SA(0, 1), cA + hstep, voffA);
        if (wr == 1) PG8_BAR;
        PG8_WAIT_V(2); PG8_BAR;
        PG8_STAGE(PG8_SB(1, 0), cB + kstep, voffB); PG8_STAGE(PG8_SA(1, 0), cA + kstep, voffA); PG8_STAGE(PG8_SB(1, 1), cB + hstep + kstep, voffB);
        PG8_WAIT_V(6); PG8_BAR;
    } else {
        PG8_STAGE(PG8_SB(0, 0), cB, voffB); PG8_STAGE(PG8_SA(0, 0), cA, voffA); PG8_STAGE(PG8_SB(0, 1), cB + hstep, voffB); PG8_STAGE(PG8_SA(0, 1), cA + hstep, voffA);
        if (wr == 1) PG8_BAR;
        PG8_WAIT_V(4); PG8_BAR;
        PG8_STAGE(PG8_SB(1, 0), cB + kstep, voffB); PG8_STAGE(PG8_SA(1, 0), cA + kstep, voffA); PG8_STAGE(PG8_SB(1, 1), cB + hstep + kstep, voffB);
        PG8_WAIT_V(6); PG8_BAR;
    }
    for (;;) {
        const bool has_next = S.next(ui + 1, nxt);
        const char* nA = has_next ? (const char*)g.A + (size_t)nxt.pm * tstep : cA; const char* nB = has_next ? (const char*)g.Bt + (size_t)nxt.pn * tstep : cB;
        for (int t = 0; t < nt; t += 2) {
            const bool last = (t == nt - 2);
            const char* a1 = cA + (size_t)(t + 1) * kstep;
            const char* a2 = last ? nA : cA + (size_t)(t + 2) * kstep; const char* b2 = last ? nB : cB + (size_t)(t + 2) * kstep;
            const char* a3 = a2 + kstep; const char* b3 = b2 + kstep;
            if (last && has_next) S.a_ready(nxt);
            if constexpr (SP2) {
            PG8_LDB(B0, 0, 0); PG8_LDB(B1, 0, 1); PG8_SCHED; PG8_LDA(At, 0, 0); PG8_STAGE(PG8_SA(1, 1), a1 + hstep, voffA);
            PG8_WAIT_V(8); PG8_WAIT_L(0); PG8_BAR; PG8_MMA(0, 0, At, B0); PG8_MMA(0, 1, At, B1); PG8_BAR; PG8_SCHED;
            PG8_LDA(At, 0, 1); PG8_STAGE(PG8_SB(0, 0), b2, voffB); PG8_STAGE(PG8_SB(0, 1), b2 + hstep, voffB); PG8_STAGE(PG8_SA(0, 0), a2, voffA);
            PG8_WAIT_V(8); PG8_WAIT_L(0); PG8_BAR; PG8_MMA(1, 0, At, B0); PG8_MMA(1, 1, At, B1); PG8_BAR; PG8_SCHED;
            PG8_LDB(B0, 1, 0); PG8_LDB(B1, 1, 1); PG8_SCHED; PG8_LDA(At, 1, 0); PG8_STAGE(PG8_SA(0, 1), a2 + hstep, voffA);
            PG8_WAIT_V(8); PG8_WAIT_L(0); PG8_BAR; PG8_MMA(0, 0, At, B0); PG8_MMA(0, 1, At, B1); PG8_BAR; PG8_SCHED;
            PG8_LDA(At, 1, 1); PG8_STAGE(PG8_SB(1, 0), b3, voffB); PG8_STAGE(PG8_SB(1, 1), b3 + hstep, voffB); PG8_STAGE(PG8_SA(1, 0), a3, voffA);
            PG8_WAIT_V(8); PG8_WAIT_L(0); PG8_BAR; PG8_MMA(1, 0, At, B0); PG8_MMA(1, 1, At, B1); PG8_BAR; PG8_SCHED;
            } else {
            PG8_LDB(B0, 0, 0); PG8_SCHED; PG8_LDA(At, 0, 0); PG8_STAGE(PG8_SA(1, 1), a1 + hstep, voffA);
            PG8_WAIT_L(8); PG8_BAR; PG8_WAIT_L(0); PG8_MMA(0, 0, At, B0); PG8_BAR; PG8_SCHED;
            PG8_LDB(B1, 0, 1); PG8_STAGE(PG8_SB(0, 0), b2, voffB);
            PG8_BAR; PG8_WAIT_L(0); PG8_MMA(0, 1, At, B1); PG8_BAR;
            PG8_LDA(At, 0, 1); PG8_STAGE(PG8_SA(0, 0), a2, voffA);
            PG8_BAR; PG8_WAIT_L(0); PG8_MMA(1, 0, At, B0); PG8_BAR; PG8_SCHED;
            PG8_STAGE(PG8_SB(0, 1), b2 + hstep, voffB);
            PG8_WAIT_V(6); PG8_BAR; PG8_MMA(1, 1, At, B1); PG8_BAR;
            PG8_LDB(B0, 1, 0); PG8_SCHED; PG8_LDA(At, 1, 0); PG8_STAGE(PG8_SA(0, 1), a2 + hstep, voffA);
            PG8_WAIT_L(8); PG8_BAR; PG8_WAIT_L(0); PG8_MMA(0, 0, At, B0); PG8_BAR; PG8_SCHED;
            PG8_LDB(B1, 1, 1); PG8_STAGE(PG8_SB(1, 0), b3, voffB);
            PG8_BAR; PG8_WAIT_L(0); PG8_MMA(0, 1, At, B1); PG8_BAR;
            PG8_LDA(At, 1, 1); PG8_STAGE(PG8_SA(1, 0), a3, voffA);
            PG8_BAR; PG8_WAIT_L(0); PG8_MMA(1, 0, At, B0); PG8_BAR; PG8_SCHED;
            PG8_STAGE(PG8_SB(1, 1), b3 + hstep, voffB);
            PG8_WAIT_V(6); PG8_BAR; PG8_MMA(1, 1, At, B1); PG8_BAR;
            }
        }
        if constexpr (ALIGN_EPI) { if (wr == 0) PG8_BAR; }
        if constexpr (!Epi::AFTER_DRAIN) { E(acc, cur, wr, wc, fr, fq, est, has_next, nxt, lds, tid); S.done(cur); }
        if (!has_next) break;
        if constexpr (!Epi::ACC_INIT) {
#pragma unroll
        for (int a = 0; a < 2; ++a)
#pragma unroll
            for (int b = 0; b < 2; ++b)
#pragma unroll
                for (int m = 0; m < 4; ++m)
#pragma unroll
                    for (int n = 0; n < 2; ++n) acc[a][b][m][n] = (f32x4){0.f, 0.f, 0.f, 0.f};
        }
        cur = nxt; cA = nA; cB = nB; ++ui;
        if constexpr (ALIGN_EPI) { if (wr == 1) PG8_BAR; }
    }
    PG8_WAIT_V(0);
    if constexpr (!ALIGN_EPI) { if (wr == 0) PG8_BAR; }
    PG8_BAR;
    if constexpr (Epi::AFTER_DRAIN) { E.fused(acc, cur, wr, wc, fr, fq, lds, wid, lane); S.done(cur); }
#undef PG8_SA
#undef PG8_SB
#undef PG8_STAGE
#undef PG8_LDA
#undef PG8_LDB
#undef PG8_MMA
#undef PG8_WAIT_V
#undef PG8_WAIT_L
#undef PG8_BAR
#undef PG8_SCHED
}
}

using pg8::bf16_t; using pg8::bf16x8; using pg8::f32x4; using pg8::Unit; using pg8::f32x2; using pg8::u32x4;
typedef unsigned u32x2 __attribute__((ext_vector_type(2)));

constexpr int D = 2048, NPROMPT = 32768, NSAMP = 256, NROWS = 33024;
constexpr int NA = 7168, NB = 5120, DMIX = 3072, DFF = 5632, DFF2 = 11264;
constexpr int CH = 16384, CHL = CH + NSAMP;
constexpr float EPS = 1e-6f;
constexpr int LDS_BYTES = pg8::STAGE_BYTES + 16;

constexpr size_t WS_WINA = 0;
constexpr size_t WS_WINB = WS_WINA + (size_t)NA * D * 2;
constexpr size_t WS_WOUT = WS_WINB + (size_t)NB * D * 2;
constexpr size_t WS_WUP = WS_WOUT + (size_t)2 * D * DMIX * 2;
constexpr size_t WS_WDOWN = WS_WUP + (size_t)2 * DFF2 * D * 2;
constexpr size_t WS_WMEM = WS_WDOWN + (size_t)2 * D * DFF * 2;
constexpr size_t WS_WM = WS_WMEM + (size_t)4096 * D * 2;
constexpr size_t WS_XB = WS_WM + (size_t)8 * 128 * 128 * 2;
constexpr size_t WS_MEMB = WS_XB + (size_t)NROWS * D * 2;
constexpr size_t WS_KB = WS_MEMB + (size_t)512 * D * 2;
constexpr size_t WS_VT = WS_KB + (size_t)20 * 256 * 1024 * 2;
constexpr size_t WS_SS = WS_VT + (size_t)20 * 256 * 1024 * 2;
constexpr size_t WS_SSM = WS_SS + (size_t)NROWS * 32 * 4;
constexpr size_t WS_STATS = WS_SSM + (size_t)512 * 32 * 4;
constexpr size_t WS_BAR = WS_STATS + (size_t)NROWS * 8;
constexpr size_t WS_BIG = WS_BAR + 16384;
static_assert(XCD_BAR_WORDS * 4 <= 16384, "barrier words");
constexpr size_t BIG_PROJ = 0, BIG_YCAT = (size_t)CHL * NA * 2, BIG_ZS = BIG_YCAT + (size_t)NROWS * DMIX * 2, BIG_HALO = BIG_ZS + (size_t)NSAMP * DFF2 * 2, BIG_H = 0;
constexpr size_t WS_END = WS_BIG + BIG_HALO + (size_t)(NPROMPT / 64) * 4 * DFF2 * 4;
static_assert((size_t)NROWS * DFF * 2 <= BIG_ZS, "h overlays proj and ycat only");
static_assert(WS_END <= ((size_t)1 << 30), "workspace over 1 GiB");

constexpr size_t O_YP = 0, O_YS = 67108864, O_CAP = 67633152, O_FCP = 67641344, O_MKP = 67731456, O_MVP = 68780032, O_CAS = 69828608, O_FCS = 69861376, O_GVS = 70221824;

struct Params { const float* in[25]; float* out; unsigned char* ws; };
enum { I_XP = 0, I_XS, I_MEM, I_CCA, I_CFC, I_CMK, I_CMV, I_GMIX, I_GMEM, I_WMK, I_WMV, I_WINA, I_CAW, I_WINB, I_GNG, I_GNB, I_GWS, I_GBIAS, I_WOUT, I_GFFN, I_WUP, I_FCW, I_FCB, I_WDOWN, I_GFIN };

__device__ __forceinline__ float bf_lo(unsigned u) { return __uint_as_float(u << 16); }
__device__ __forceinline__ float bf_hi(unsigned u) { return __uint_as_float(u & 0xffff0000u); }
__device__ __forceinline__ unsigned pk(float a, float b) { return pg8::cvt_pk_bf16(a, b); }
__device__ __forceinline__ void unpack8(const u32x4 r, float (&f)[8]) { f[0] = bf_lo(r.x); f[1] = bf_hi(r.x); f[2] = bf_lo(r.y); f[3] = bf_hi(r.y); f[4] = bf_lo(r.z); f[5] = bf_hi(r.z); f[6] = bf_lo(r.w); f[7] = bf_hi(r.w); }
__device__ __forceinline__ u32x4 pack8(const float (&f)[8]) { u32x4 w; w.x = pk(f[0], f[1]); w.y = pk(f[2], f[3]); w.z = pk(f[4], f[5]); w.w = pk(f[6], f[7]); return w; }
__device__ __forceinline__ int lrow(int row, int rows0) { return row < NPROMPT ? row - rows0 : row - NPROMPT + CH; }

template <int X1, int X2> __device__ __forceinline__ float rowscale(const float* ss, int row, int part) {
    const f32x4* q = (const f32x4*)(ss + (size_t)row * 32 + part * 8);
    const f32x4 a = q[0], b = q[1];
    float s = ((a[0] + a[1]) + (a[2] + a[3])) + ((b[0] + b[1]) + (b[2] + b[3]));
    s += __shfl_xor(s, X1); s += __shfl_xor(s, X2);
    return rsqrtf(s * (1.0f / 2048.0f) + EPS);
}

struct OpScale {
    static constexpr bool SUMSQ = false, NEEDS_RS = true, PRELOAD = false;
    const float* ss; bf16_t* dst; int ld, rows0, gelu_cols;
    struct Row { bf16_t* dp; float rs; bool gelu; };
    __device__ __forceinline__ const float* ssin() const { return ss; }
    __device__ __forceinline__ Row begin_row(int row, int col0, float rs) const { Row r; r.rs = rs; r.dp = dst + (size_t)lrow(row, rows0) * ld + col0; r.gelu = col0 < gelu_cols; return r; }
    __device__ __forceinline__ f32x4 load4(const Row&, int) const { return (f32x4){0.f, 0.f, 0.f, 0.f}; }
    __device__ __forceinline__ f32x4 act(const Row& r, f32x4 v) const {
        v = v * r.rs;
        if (r.gelu) { const f32x2 a = pg8::gelu_pk((f32x2){v[0], v[1]}), b = pg8::gelu_pk((f32x2){v[2], v[3]}); v = (f32x4){a.x, a.y, b.x, b.y}; }
        return v;
    }
    __device__ __forceinline__ void store4(const Row& r, int coff, f32x4 v, f32x4, float&) const {
        v = act(r, v); u32x2 w; w.x = pk(v[0], v[1]); w.y = pk(v[2], v[3]);
        *(u32x2*)(r.dp + coff) = w;
    }
    __device__ __forceinline__ void store8(const Row& r, int coff, f32x4 v0, f32x4 v1, f32x4, f32x4, float&) const {
        v0 = act(r, v0); v1 = act(r, v1); u32x4 w; w.x = pk(v0[0], v0[1]); w.y = pk(v0[2], v0[3]); w.z = pk(v1[0], v1[1]); w.w = pk(v1[2], v1[3]);
        *(u32x4*)(r.dp + coff) = w;
    }
    __device__ __forceinline__ void end_row(int, int, float) const {}
};
struct OpResid {
    static constexpr bool SUMSQ = true, NEEDS_RS = false, PRELOAD = true;
    bf16_t* xb; float* ss;
    struct Row { unsigned xo; };
    __device__ __forceinline__ const float* ssin() const { return nullptr; }
    __device__ __forceinline__ Row begin_row(int row, int col0, float) const { Row r; r.xo = (unsigned)row * D + col0; return r; }
    __device__ __forceinline__ f32x4 load4(const Row& r, int coff) const { const u32x2 w = *(const u32x2*)(xb + (size_t)r.xo + coff); return (f32x4){bf_lo(w.x), bf_hi(w.x), bf_lo(w.y), bf_hi(w.y)}; }
    __device__ __forceinline__ void store4(const Row& r, int coff, f32x4 v, f32x4 pre, float& sq) const {
        const f32x4 x = pre + v;
        u32x2 w; w.x = pk(x[0], x[1]); w.y = pk(x[2], x[3]);
        *(u32x2*)(xb + (size_t)r.xo + coff) = w;
        sq += (x[0] * x[0] + x[1] * x[1]) + (x[2] * x[2] + x[3] * x[3]);
    }
    __device__ __forceinline__ void store8(const Row& r, int coff, f32x4 v0, f32x4 v1, f32x4 p0, f32x4 p1, float& sq) const {
        const f32x4 x0 = p0 + v0, x1 = p1 + v1;
        u32x4 w; w.x = pk(x0[0], x0[1]); w.y = pk(x0[2], x0[3]); w.z = pk(x1[0], x1[1]); w.w = pk(x1[2], x1[3]);
        *(u32x4*)(xb + (size_t)r.xo + coff) = w;
        sq += ((x0[0] * x0[0] + x0[1] * x0[1]) + (x0[2] * x0[2] + x0[3] * x0[3])) + ((x1[0] * x1[0] + x1[1] * x1[1]) + (x1[2] * x1[2] + x1[3] * x1[3]));
    }
    __device__ __forceinline__ u32x4 load8raw_at(int row, int col) const { return *(const u32x4*)(xb + (size_t)row * D + col); }
    __device__ __forceinline__ void store8x(const Row& r, int coff, f32x4 x0, f32x4 x1, float& sq) const {
        u32x4 w; w.x = pk(x0[0], x0[1]); w.y = pk(x0[2], x0[3]); w.z = pk(x1[0], x1[1]); w.w = pk(x1[2], x1[3]);
        *(u32x4*)(xb + (size_t)r.xo + coff) = w;
        sq += ((x0[0] * x0[0] + x0[1] * x0[1]) + (x0[2] * x0[2] + x0[3] * x0[3])) + ((x1[0] * x1[0] + x1[1] * x1[1]) + (x1[2] * x1[2] + x1[3] * x1[3]));
    }
    __device__ __forceinline__ void end_row(int row, int part, float sq) const { ss[(size_t)row * 32 + part] = sq; }
};
struct OpMemKV {
    static constexpr bool SUMSQ = false, NEEDS_RS = true, PRELOAD = false;
    const float* ssm; float* out_k; float* out_v; bf16_t* Kb; bf16_t* Vt;
    struct Row { float* o; bf16_t* kb; bf16_t* vt; float rs; };
    __device__ __forceinline__ const float* ssin() const { return ssm; }
    __device__ __forceinline__ Row begin_row(int row, int col0, float rs) const {
        Row r; r.rs = rs;
        const int layer = col0 >> 11, isv = (col0 >> 10) & 1, c = col0 & 1023, b = row >> 8, m = row & 255, bbi = layer * 10 + 8 + b;
        r.o = (isv ? out_v : out_k) + ((size_t)((layer * 2 + b) * 256 + m)) * 1024 + c;
        r.kb = isv ? nullptr : Kb + ((size_t)bbi * 256 + m) * 1024 + c;
        r.vt = Vt + ((size_t)bbi * 1024 + c) * 256 + m;
        return r;
    }
    __device__ __forceinline__ f32x4 load4(const Row&, int) const { return (f32x4){0.f, 0.f, 0.f, 0.f}; }
    __device__ __forceinline__ void store4(const Row& r, int coff, f32x4 v, f32x4, float&) const {
        v = v * r.rs;
        *(f32x4*)(r.o + coff) = v;
        const unsigned w0 = pk(v[0], v[1]), w1 = pk(v[2], v[3]);
        if (r.kb) { u32x2 w; w.x = w0; w.y = w1; *(u32x2*)(r.kb + coff) = w; }
        else { bf16_t* t = r.vt + (size_t)coff * 256; t[0] = (bf16_t)(w0 & 0xffffu); t[256] = (bf16_t)(w0 >> 16); t[512] = (bf16_t)(w1 & 0xffffu); t[768] = (bf16_t)(w1 >> 16); }
    }
    __device__ __forceinline__ void end_row(int, int, float) const {}
};

template <class Op> struct EpiG {
    static constexpr bool PERM = true, APERM = false, AFTER_DRAIN = false, ACC_INIT = Op::PRELOAD;
    Op op; int row_base;
    struct State { int pm; f32x4 ra, rb; };
    __device__ __forceinline__ void init_state(State& st, const Unit&, PG8_LAS unsigned char*, int) const {
        st.pm = -1; st.ra = (f32x4){1.f, 1.f, 1.f, 1.f}; st.rb = st.ra;
    }
    __device__ __forceinline__ void init_acc(f32x4 (&acc)[2][2][4][2], const Unit& u, int wr, int wc, int fr, int fq) const {
        if constexpr (Op::PRELOAD) {
            const int row0 = row_base + u.pm * 256 + wr * 64 + fr, col0 = u.pn * 256 + wc * 32 + 8 * fq;
            u32x4 raw[8][2];
#pragma unroll
            for (int i = 0; i < 8; ++i)
#pragma unroll
                for (int bj = 0; bj < 2; ++bj) raw[i][bj] = op.load8raw_at(row0 + (i >> 2) * 128 + (i & 3) * 16, col0 + bj * 128);
#pragma unroll
            for (int i = 0; i < 8; ++i)
#pragma unroll
                for (int bj = 0; bj < 2; ++bj) { const u32x4 r = raw[i][bj]; acc[i >> 2][bj][i & 3][0] = (f32x4){bf_lo(r.x), bf_hi(r.x), bf_lo(r.y), bf_hi(r.y)}; acc[i >> 2][bj][i & 3][1] = (f32x4){bf_lo(r.z), bf_hi(r.z), bf_lo(r.w), bf_hi(r.w)}; }
        }
    }
    __device__ __forceinline__ void operator()(f32x4 (&acc)[2][2][4][2], const Unit& u, int wr, int wc, int fr, int fq, State& st, bool has_next, const Unit& nxt, PG8_LAS unsigned char*, int) const {
        const int row0 = row_base + u.pm * 256 + wr * 64 + fr, col0 = u.pn * 256 + wc * 32 + 8 * fq;
        if constexpr (Op::NEEDS_RS) {
            if (u.pm != st.pm) {
                const float* sp = op.ssin() + (size_t)row0 * 32 + fq * 8;
                f32x4 pa[8], pb[8];
#pragma unroll
                for (int i = 0; i < 8; ++i) { const float* q = sp + (size_t)((i >> 2) * 128 + (i & 3) * 16) * 32; pa[i] = *(const f32x4*)q; pb[i] = *(const f32x4*)(q + 4); }
#pragma unroll
                for (int i = 0; i < 8; ++i) { float s = ((pa[i][0] + pa[i][1]) + (pa[i][2] + pa[i][3])) + ((pb[i][0] + pb[i][1]) + (pb[i][2] + pb[i][3]));
                    s += __shfl_xor(s, 16); s += __shfl_xor(s, 32); const float r = rsqrtf(s * (1.0f / 2048.0f) + EPS); if (i < 4) st.ra[i & 3] = r; else st.rb[i & 3] = r; }
                st.pm = u.pm;
            }
        }
        if constexpr (Op::PRELOAD) {
            u32x4 raw[8][2];
            if (has_next) {
                const int nrow0 = row_base + nxt.pm * 256 + wr * 64 + fr, ncol0 = nxt.pn * 256 + wc * 32 + 8 * fq;
#pragma unroll
                for (int i = 0; i < 8; ++i)
#pragma unroll
                    for (int bj = 0; bj < 2; ++bj) raw[i][bj] = op.load8raw_at(nrow0 + (i >> 2) * 128 + (i & 3) * 16, ncol0 + bj * 128);
            }
#pragma unroll
            for (int i = 0; i < 8; ++i) {
                const typename Op::Row rc = op.begin_row(row0 + (i >> 2) * 128 + (i & 3) * 16, col0, 1.f); float sq = 0.f;
#pragma unroll
                for (int bj = 0; bj < 2; ++bj) op.store8x(rc, bj * 128, acc[i >> 2][bj][i & 3][0], acc[i >> 2][bj][i & 3][1], sq);
                if (Op::SUMSQ) { sq += __shfl_xor(sq, 16); sq += __shfl_xor(sq, 32); if (fq == 0) op.end_row(row0 + (i >> 2) * 128 + (i & 3) * 16, u.pn * 4 + wc, sq); }
            }
            if (has_next) {
#pragma unroll
                for (int i = 0; i < 8; ++i)
#pragma unroll
                    for (int bj = 0; bj < 2; ++bj) { const u32x4 r = raw[i][bj]; acc[i >> 2][bj][i & 3][0] = (f32x4){bf_lo(r.x), bf_hi(r.x), bf_lo(r.y), bf_hi(r.y)}; acc[i >> 2][bj][i & 3][1] = (f32x4){bf_lo(r.z), bf_hi(r.z), bf_lo(r.w), bf_hi(r.w)}; }
            }
        } else {
            const f32x4 z4 = (f32x4){0.f, 0.f, 0.f, 0.f};
#pragma unroll
            for (int ai = 0; ai < 2; ++ai)
#pragma unroll
                for (int m = 0; m < 4; ++m) {
                    const typename Op::Row rc = op.begin_row(row0 + ai * 128 + m * 16, col0, ai ? st.rb[m] : st.ra[m]); float sq = 0.f;
#pragma unroll
                    for (int bj = 0; bj < 2; ++bj) op.store8(rc, bj * 128, acc[ai][bj][m][0], acc[ai][bj][m][1], z4, z4, sq);
                }
        }
    }
};

__device__ __forceinline__ float dpp_shr1(float v) { return __builtin_bit_cast(float, __builtin_amdgcn_update_dpp(0, __builtin_bit_cast(int, v), 0x111, 0xf, 0xf, true)); }
struct EpiFfn {
    static constexpr bool PERM = true, APERM = true, AFTER_DRAIN = false, ACC_INIT = false;
    const float* ss; const float* cw; const float* cb; bf16_t* h; float* halo; int row_base;
    struct State { int pm; f32x4 ra, rb; int slot; };
    __device__ __forceinline__ void init_acc(f32x4 (&)[2][2][4][2], const Unit&, int, int, int, int) const {}
    __device__ __forceinline__ const float* slice_src(int pn, int tid) const {
        const int a = tid >> 6, cl = (tid & 63) * 2;
        const float* base = (a & 3) < 3 ? cw + (size_t)(a & 3) * DFF2 : cb;
        return base + (a >> 2) * DFF + pn * 128 + cl;
    }
    __device__ __forceinline__ void init_state(State& st, const Unit& u, PG8_LAS unsigned char* lds, int tid) const {
        st.pm = -1; st.slot = 0; st.ra = (f32x4){1.f, 1.f, 1.f, 1.f}; st.rb = st.ra;
    }
    __device__ __forceinline__ void operator()(const f32x4 (&acc)[2][2][4][2], const Unit& u, int wr, int wc, int fr, int fq, State& st, bool has_next, const Unit& nxt, PG8_LAS unsigned char* lds, int tid) const {
        const int lrow0 = u.pm * 256 + wr * 64 + 4 * fr, c0 = u.pn * 128 + wc * 32 + 8 * fq;
        if (u.pm != st.pm) {
            const float* sp = ss + (size_t)(row_base + lrow0) * 32 + fq * 8;
            f32x4 pa[8], pb[8];
#pragma unroll
            for (int i = 0; i < 8; ++i) { const float* q = sp + (size_t)((i >> 2) * 128 + (i & 3)) * 32; pa[i] = *(const f32x4*)q; pb[i] = *(const f32x4*)(q + 4); }
#pragma unroll
            for (int i = 0; i < 8; ++i) { float s = ((pa[i][0] + pa[i][1]) + (pa[i][2] + pa[i][3])) + ((pb[i][0] + pb[i][1]) + (pb[i][2] + pb[i][3]));
                s += __shfl_xor(s, 16); s += __shfl_xor(s, 32); const float r = rsqrtf(s * (1.0f / 2048.0f) + EPS); if (i < 4) st.ra[i & 3] = r; else st.rb[i & 3] = r; }
            st.pm = u.pm;
        }
        u32x2 res[8];
#pragma unroll
        for (int n = 0; n < 2; ++n) {
            const int cc = c0 + 4 * n;
            const f32x4 wa0 = *(const f32x4*)(cw + cc), wa1 = *(const f32x4*)(cw + DFF2 + cc), wa2 = *(const f32x4*)(cw + 2 * DFF2 + cc), ba = *(const f32x4*)(cb + cc);
            const f32x4 wg0 = *(const f32x4*)(cw + DFF + cc), wg1 = *(const f32x4*)(cw + DFF2 + DFF + cc), wg2 = *(const f32x4*)(cw + 2 * DFF2 + DFF + cc), bg = *(const f32x4*)(cb + DFF + cc);
#pragma unroll
            for (int ai = 0; ai < 2; ++ai) {
                const int blk = u.pm * 4 + ai * 2 + wr;
                f32x4 za[4], zg[4];
#pragma unroll
                for (int m = 0; m < 4; ++m) { const float r = ai ? st.rb[m] : st.ra[m]; za[m] = acc[ai][0][m][n] * r; zg[m] = acc[ai][1][m][n] * r; }
                f32x4 la2, la3, lg2, lg3;
#pragma unroll
                for (int j = 0; j < 4; ++j) { la2[j] = dpp_shr1(za[2][j]); la3[j] = dpp_shr1(za[3][j]); lg2[j] = dpp_shr1(zg[2][j]); lg3[j] = dpp_shr1(zg[3][j]); }
#pragma unroll
                for (int m = 0; m < 4; ++m) {
                    const f32x4 p2a = m == 0 ? la2 : (m == 1 ? la3 : za[m >= 2 ? m - 2 : 0]), p1a = m == 0 ? la3 : za[m >= 1 ? m - 1 : 0];
                    const f32x4 p2g = m == 0 ? lg2 : (m == 1 ? lg3 : zg[m >= 2 ? m - 2 : 0]), p1g = m == 0 ? lg3 : zg[m >= 1 ? m - 1 : 0];
                    const f32x4 ca = wa0 * p2a + wa1 * p1a + wa2 * za[m] + ba;
                    const f32x4 cg = wg0 * p2g + wg1 * p1g + wg2 * zg[m] + bg;
                    f32x4 o;
#pragma unroll
                    for (int j = 0; j < 4; ++j) o[j] = ca[j] * cg[j] * __builtin_amdgcn_rcpf(1.0f + __builtin_amdgcn_exp2f(-1.44269504089f * cg[j]));
                    if ((fr == 0 && m < 2) || (fr == 15 && m >= 2)) { float* hp = halo + ((size_t)(blk * 4 + m)) * DFF2 + cc; *(f32x4*)hp = za[m]; *(f32x4*)(hp + DFF) = zg[m]; }
                    u32x2 w; w.x = pk(o[0], o[1]); w.y = pk(o[2], o[3]);
                    if (n == 0) res[ai * 4 + m] = w;
                    else { u32x4 w4; w4.x = res[ai * 4 + m].x; w4.y = res[ai * 4 + m].y; w4.z = w.x; w4.w = w.y; *(u32x4*)(h + (size_t)(lrow0 + ai * 128 + m) * DFF + c0) = w4; }
                }
            }
        }
    }
};

constexpr int RP = 68;
template <class Op>
__device__ __forceinline__ void small_gemm(const bf16_t* A, int lda, const bf16_t* Bt, int M, int N, int K, const Op& op, int row_base, unsigned char* shm) {
    const int tid = otid(), lane = tid & 63, wid = tid >> 6, fr = lane & 15, fq = lane >> 4;
    float* red = (float*)shm;
    const int nmt = M / 32, ntiles = nmt * (N / 64), kw = K / 8;
    for (int t = blockIdx.x; t < ntiles; t += gridDim.x) {
        const int tm = t % nmt, tn = t / nmt;
        const bf16_t* ap = A + (size_t)(tm * 32 + fr) * lda + wid * kw + fq * 8;
        const bf16_t* bp = Bt + (size_t)(tn * 64 + fr) * K + wid * kw + fq * 8;
        f32x4 acc[2][4];
#pragma unroll
        for (int mt = 0; mt < 2; ++mt)
#pragma unroll
            for (int n = 0; n < 4; ++n) acc[mt][n] = (f32x4){0.f, 0.f, 0.f, 0.f};
#pragma unroll 4
        for (int k = 0; k < kw; k += 32) {
            const bf16x8 a0 = *(const bf16x8*)(ap + k), a1 = *(const bf16x8*)(ap + (size_t)16 * lda + k);
#pragma unroll
            for (int n = 0; n < 4; ++n) { const bf16x8 b = *(const bf16x8*)(bp + (size_t)n * 16 * K + k);
                acc[0][n] = __builtin_amdgcn_mfma_f32_16x16x32_bf16(b, a0, acc[0][n], 0, 0, 0); acc[1][n] = __builtin_amdgcn_mfma_f32_16x16x32_bf16(b, a1, acc[1][n], 0, 0, 0); }
        }
#pragma unroll
        for (int mt = 0; mt < 2; ++mt)
#pragma unroll
            for (int n = 0; n < 4; ++n) *(f32x4*)(red + (wid * 32 + mt * 16 + fr) * RP + n * 16 + 4 * fq) = acc[mt][n];
        __syncthreads();
        const int rl = wid * 4 + (lane >> 4), c4 = (lane & 15) * 4;
        f32x4 v = *(const f32x4*)(red + rl * RP + c4);
#pragma unroll
        for (int w = 1; w < 8; ++w) v += *(const f32x4*)(red + (w * 32 + rl) * RP + c4);
        const int row = row_base + tm * 32 + rl;
        float rs = 1.f; if (Op::NEEDS_RS) rs = rowscale<1, 2>(op.ssin(), row, lane & 3);
        const typename Op::Row rc = op.begin_row(row, tn * 64 + c4, rs); float sq = 0.f;
        f32x4 pre = (f32x4){0.f, 0.f, 0.f, 0.f}; if (Op::PRELOAD) pre = op.load4(rc, 0);
        op.store4(rc, 0, v, pre, sq);
        if (Op::SUMSQ) { sq += __shfl_xor(sq, 1); sq += __shfl_xor(sq, 2); sq += __shfl_xor(sq, 4); sq += __shfl_xor(sq, 8); if ((lane & 15) == 0) op.end_row(row, tn, sq); }
        __syncthreads();
    }
}

__device__ __forceinline__ int up_perm(int n) { return n < DFF ? (n >> 7) * 256 + (n & 127) : ((n - DFF) >> 7) * 256 + 128 + ((n - DFF) & 127); }
__device__ __forceinline__ void tjob(const float* src, const float* gain, bf16_t* dst, int K, int N, int nb, size_t sbs, size_t dbs, int& tile0, float* lf, bool perm = false) {
    const int tid = otid(), G = gridDim.x;
    const int nkt = K / 256, nnt = N / 64, tpb = nkt * nnt, ntile = tpb * nb;
    int first = ((int)blockIdx.x - tile0) % G; if (first < 0) first += G;
    for (int tt = first; tt < ntile; tt += G) {
        const int batch = tt / tpb, rem = tt % tpb, kt = rem % nkt, nt = rem / nkt;
        const float* s = src + (size_t)batch * sbs + (size_t)(kt * 256) * N + nt * 64;
        f32x4 v[8];
#pragma unroll
        for (int i = 0; i < 8; ++i) { const int idx = tid + 512 * i, kr = idx >> 4, c4 = idx & 15; v[i] = *(const f32x4*)(s + (size_t)kr * N + c4 * 4); }
#pragma unroll
        for (int i = 0; i < 8; ++i) {
            const int idx = tid + 512 * i, kr = idx >> 4, c4 = idx & 15;
            const float gk = gain ? gain[kt * 256 + kr] : 1.0f;
            float* l = lf + kr * 65 + c4 * 4; l[0] = v[i][0] * gk; l[1] = v[i][1] * gk; l[2] = v[i][2] * gk; l[3] = v[i][3] * gk;
        }
        __syncthreads();
        bf16_t* d = dst + (size_t)batch * dbs + (size_t)(perm ? up_perm(nt * 64) : nt * 64) * K + kt * 256;
#pragma unroll
        for (int i = 0; i < 4; ++i) {
            const int idx = tid + 512 * i, k8 = (idx >> 10) * 16 + (idx & 15), n = (idx >> 4) & 63;
            const float* l = lf + (k8 * 8) * 65 + n;
            u32x4 w; w.x = pk(l[0], l[65]); w.y = pk(l[130], l[195]); w.z = pk(l[260], l[325]); w.w = pk(l[390], l[455]);
            *(u32x4*)(d + (size_t)n * K + k8 * 8) = w;
        }
        __syncthreads();
    }
    tile0 += ntile;
}

__device__ __forceinline__ void prep_phase(const Params& p, unsigned char* shm) {
    unsigned char* ws = p.ws; float* lf = (float*)shm;
    const int tid = otid(), lane = tid & 63, wid = tid >> 6, G = gridDim.x;
    int t0 = 0;
    tjob(p.in[I_WINA], p.in[I_GMIX], (bf16_t*)(ws + WS_WINA), D, NA, 1, 0, 0, t0, lf);
    tjob(p.in[I_WINB], p.in[I_GMIX] + D, (bf16_t*)(ws + WS_WINB), D, NB, 1, 0, 0, t0, lf);
    tjob(p.in[I_WOUT], nullptr, (bf16_t*)(ws + WS_WOUT), DMIX, D, 2, (size_t)DMIX * D, (size_t)DMIX * D, t0, lf);
    tjob(p.in[I_WUP], p.in[I_GFFN], (bf16_t*)(ws + WS_WUP), D, DFF2, 1, 0, 0, t0, lf, true);
    tjob(p.in[I_WUP] + (size_t)D * DFF2, p.in[I_GFFN] + D, (bf16_t*)(ws + WS_WUP) + (size_t)D * DFF2, D, DFF2, 1, 0, 0, t0, lf, true);
    tjob(p.in[I_WDOWN], nullptr, (bf16_t*)(ws + WS_WDOWN), DFF, D, 2, (size_t)DFF * D, (size_t)DFF * D, t0, lf);
    tjob(p.in[I_WMK], p.in[I_GMEM], (bf16_t*)(ws + WS_WMEM), D, 1024, 1, 0, 0, t0, lf);
    tjob(p.in[I_WMV], p.in[I_GMEM], (bf16_t*)(ws + WS_WMEM) + (size_t)1024 * D, D, 1024, 1, 0, 0, t0, lf);
    tjob(p.in[I_WMK] + (size_t)D * 1024, p.in[I_GMEM] + D, (bf16_t*)(ws + WS_WMEM) + (size_t)2048 * D, D, 1024, 1, 0, 0, t0, lf);
    tjob(p.in[I_WMV] + (size_t)D * 1024, p.in[I_GMEM] + D, (bf16_t*)(ws + WS_WMEM) + (size_t)3072 * D, D, 1024, 1, 0, 0, t0, lf);
    tjob(p.in[I_CMV], nullptr, (bf16_t*)(ws + WS_VT), 256, 1024, 8, (size_t)262144, (size_t)262144, t0, lf);
    tjob(p.in[I_CMV] + (size_t)8 * 262144, nullptr, (bf16_t*)(ws + WS_VT) + (size_t)10 * 262144, 256, 1024, 8, (size_t)262144, (size_t)262144, t0, lf);
    {
        bf16_t* xb = (bf16_t*)(ws + WS_XB); bf16_t* memb = (bf16_t*)(ws + WS_MEMB); float* ss = (float*)(ws + WS_SS); float* ssm = (float*)(ws + WS_SSM);
        for (int row = blockIdx.x * 8 + wid; row < NROWS + 512; row += G * 8) {
            const float* src; bf16_t* db; float* sp;
            if (row < NPROMPT) { src = p.in[I_XP] + (size_t)row * D; db = xb + (size_t)row * D; sp = ss + (size_t)row * 32; }
            else if (row < NROWS) { src = p.in[I_XS] + (size_t)(row - NPROMPT) * D; db = xb + (size_t)row * D; sp = ss + (size_t)row * 32; }
            else { src = p.in[I_MEM] + (size_t)(row - NROWS) * D; db = memb + (size_t)(row - NROWS) * D; sp = ssm + (size_t)(row - NROWS) * 32; }
            float sq = 0.f;
#pragma unroll
            for (int i = 0; i < 8; ++i) {
                const f32x4 v = *(const f32x4*)(src + (i * 64 + lane) * 4);
                sq += (v[0] * v[0] + v[1] * v[1]) + (v[2] * v[2] + v[3] * v[3]);
                u32x2 w; w.x = pk(v[0], v[1]); w.y = pk(v[2], v[3]);
                *(u32x2*)(db + (i * 64 + lane) * 4) = w;
            }
#pragma unroll
            for (int o = 32; o >= 1; o >>= 1) sq += __shfl_xor(sq, o);
            if (lane < 32) sp[lane] = lane == 0 ? sq : 0.f;
        }
    }
    {
        bf16_t* Kb = (bf16_t*)(ws + WS_KB);
        const size_t n4 = (size_t)2 * 8 * 262144 / 4;
        for (size_t i = (size_t)blockIdx.x * 512 + tid; i < n4; i += (size_t)G * 512) {
            const f32x4 v = *(const f32x4*)(p.in[I_CMK] + i * 4);
            const size_t e = i * 4, lb = e / 262144, r = e % 262144, layer = lb / 8, b = lb % 8;
            u32x2 w; w.x = pk(v[0], v[1]); w.y = pk(v[2], v[3]);
            *(u32x2*)(Kb + (layer * 10 + b) * 262144 + r) = w;
        }
        bf16_t* Wm = (bf16_t*)(ws + WS_WM);
        for (int i = blockIdx.x * 512 + tid; i < 8 * 128 * 128; i += G * 512) {
            const int s = i & 127, t = (i >> 7) & 127;
            const float v = s <= t ? p.in[I_GWS][i] : 0.f;
            Wm[i] = (bf16_t)(pk(v, 0.f) & 0xffffu);
        }
    }
}

__device__ __forceinline__ void mixa_rows(const Params& p, const bf16_t* proj, bf16_t* ycat, int rows0, int r0, int r1, int seq0, int seq1, const float* prev, float* state_out, int ch0) {
    const float* cw = p.in[I_CAW];
    float w0[8], w1[8], w2[8], zm2[8], zm1[8];
#pragma unroll
    for (int i = 0; i < 8; ++i) { w0[i] = cw[ch0 + i]; w1[i] = cw[D + ch0 + i]; w2[i] = cw[2 * D + ch0 + i]; }
    {
        const int ra = r0 - 2, rb = r0 - 1;
        if (ra >= seq0) { const bf16_t* q = proj + (size_t)lrow(ra, rows0) * NA; float c[8], h[8]; unpack8(*(const u32x4*)(q + D + ch0), c); unpack8(*(const u32x4*)(q + 2 * D + ch0), h);
#pragma unroll
            for (int i = 0; i < 8; ++i) zm2[i] = c[i] * h[i]; }
        else {
#pragma unroll
            for (int i = 0; i < 8; ++i) zm2[i] = prev ? prev[(ra - seq0 + 2) * D + ch0 + i] : 0.f; }
        if (rb >= seq0) { const bf16_t* q = proj + (size_t)lrow(rb, rows0) * NA; float c[8], h[8]; unpack8(*(const u32x4*)(q + D + ch0), c); unpack8(*(const u32x4*)(q + 2 * D + ch0), h);
#pragma unroll
            for (int i = 0; i < 8; ++i) zm1[i] = c[i] * h[i]; }
        else {
#pragma unroll
            for (int i = 0; i < 8; ++i) zm1[i] = prev ? prev[(rb - seq0 + 2) * D + ch0 + i] : 0.f; }
    }
    int r = r0;
    for (; r + 4 <= r1; r += 4) {
        u32x4 vb[4], vc[4], vh[4];
#pragma unroll
        for (int k = 0; k < 4; ++k) { const bf16_t* q = proj + (size_t)lrow(r + k, rows0) * NA; vb[k] = *(const u32x4*)(q + ch0); vc[k] = *(const u32x4*)(q + D + ch0); vh[k] = *(const u32x4*)(q + 2 * D + ch0); }
#pragma unroll
        for (int k = 0; k < 4; ++k) {
            float b[8], c[8], h[8], y[8], z[8];
            unpack8(vb[k], b); unpack8(vc[k], c); unpack8(vh[k], h);
#pragma unroll
            for (int i = 0; i < 8; ++i) { z[i] = c[i] * h[i]; y[i] = b[i] * (w0[i] * zm2[i] + w1[i] * zm1[i] + w2[i] * z[i]); zm2[i] = zm1[i]; zm1[i] = z[i]; }
            *(u32x4*)(ycat + (size_t)(r + k) * DMIX + ch0) = pack8(y);
            if (r + k >= seq1 - 2) { float* so = state_out + (size_t)(r + k - (seq1 - 2)) * D + ch0; *(f32x4*)so = (f32x4){z[0], z[1], z[2], z[3]}; *(f32x4*)(so + 4) = (f32x4){z[4], z[5], z[6], z[7]}; }
        }
    }
    for (; r < r1; ++r) {
        const bf16_t* q = proj + (size_t)lrow(r, rows0) * NA;
        float b[8], c[8], h[8], y[8], z[8];
        unpack8(*(const u32x4*)(q + ch0), b); unpack8(*(const u32x4*)(q + D + ch0), c); unpack8(*(const u32x4*)(q + 2 * D + ch0), h);
#pragma unroll
        for (int i = 0; i < 8; ++i) { z[i] = c[i] * h[i]; y[i] = b[i] * (w0[i] * zm2[i] + w1[i] * zm1[i] + w2[i] * z[i]); zm2[i] = zm1[i]; zm1[i] = z[i]; }
        *(u32x4*)(ycat + (size_t)r * DMIX + ch0) = pack8(y);
        if (r >= seq1 - 2) { float* so = state_out + (size_t)(r - (seq1 - 2)) * D + ch0; *(f32x4*)so = (f32x4){z[0], z[1], z[2], z[3]}; *(f32x4*)(so + 4) = (f32x4){z[4], z[5], z[6], z[7]}; }
    }
}
__device__ __forceinline__ void mixa_phase(const Params& p, const bf16_t* proj, bf16_t* ycat, int chunk, bool has_s) {
    const int lane = otid() & 63, wid = otid() >> 6, half = wid >> 2, ch0 = (wid & 3) * 512 + lane * 8, rows0 = chunk * CH;
    for (int it = blockIdx.x; it < CH / 64; it += gridDim.x) {
        const int r0 = rows0 + it * 64 + half * 32;
        mixa_rows(p, proj, ycat, rows0, r0, r0 + 32, rows0, rows0 + CH, nullptr, p.out + O_CAP + (size_t)chunk * 2 * D, ch0);
    }
    if (has_s && half == 0)
        for (int it = blockIdx.x; it < NSAMP; it += gridDim.x) {
            const int b = it >> 5, row = NPROMPT + it, s0 = NPROMPT + b * 32;
            mixa_rows(p, proj, ycat, rows0, row, row + 1, s0, s0 + 32, p.in[I_CCA] + (size_t)b * 2 * D, p.out + O_CAS + (size_t)b * 2 * D, ch0);
        }
}

template <bool ISK> __device__ __forceinline__ void attn_fill(unsigned char* shm, const bf16_t* src, int gpitch) {
    const int tid = otid();
    u32x4 v[16];
#pragma unroll
    for (int i = 0; i < 16; ++i) { const int idx = tid + 512 * i, r = idx >> 5, c = idx & 31; v[i] = *(const u32x4*)(src + (size_t)r * gpitch + c * 8); }
#pragma unroll
    for (int i = 0; i < 16; ++i) { const int idx = tid + 512 * i, r = idx >> 5, c = idx & 31; const int f = ISK ? ((r & 3) | (((r >> 3) & 3) << 2)) : (r & 15);
        *(u32x4*)(shm + r * 512 + ((c ^ f) << 4)) = v[i]; }
}
__device__ __forceinline__ void attn_block(const bf16_t* qb, int ldp, const bf16_t* Kg, const bf16_t* Vg, bf16_t* ob, int ngroups, unsigned char* shm) {
    const int tid = otid(), lane = tid & 63, wid = tid >> 6, fr = lane & 15, fq = lane >> 4;
    int offs[4];
#pragma unroll
    for (int b2 = 0; b2 < 4; ++b2) offs[b2] = ((b2 ^ (fr >> 2)) << 6) + ((fq ^ (fr & 3)) << 4);
    const int rbk = (8 * (fr >> 2) + (fr & 3)) * 512, rbv = fr * 512;
    __syncthreads();
    attn_fill<true>(shm, Kg, 1024);
    __syncthreads();
    bf16x8 pf[2][8]; float inv[2];
#pragma unroll
    for (int gi = 0; gi < 2; ++gi) {
        const int grp = wid + 8 * gi;
        if (grp < ngroups) {
            const bf16_t* qg = qb + (size_t)(grp * 16 + fr) * ldp + fq * 8;
            bf16x8 q[8];
#pragma unroll
            for (int ks = 0; ks < 8; ++ks) q[ks] = *(const bf16x8*)(qg + ks * 32);
            f32x4 s[16];
#pragma unroll
            for (int nt = 0; nt < 16; ++nt) {
                f32x4 a = (f32x4){0.f, 0.f, 0.f, 0.f};
#pragma unroll
                for (int ks = 0; ks < 8; ++ks) { const bf16x8 kf = *(const bf16x8*)(shm + (nt >> 1) * 16384 + (nt & 1) * 2048 + rbk + (ks >> 2) * 256 + offs[ks & 3]); a = __builtin_amdgcn_mfma_f32_16x16x32_bf16(kf, q[ks], a, 0, 0, 0); }
                s[nt] = a;
            }
            float mx = -3.0e38f;
#pragma unroll
            for (int nt = 0; nt < 16; ++nt) mx = fmaxf(fmaxf(fmaxf(s[nt][0], s[nt][1]), fmaxf(s[nt][2], s[nt][3])), mx);
            mx = fmaxf(mx, __shfl_xor(mx, 16)); mx = fmaxf(mx, __shfl_xor(mx, 32));
            const float sc = 0.0625f * 1.44269504089f; float sum = 0.f;
#pragma unroll
            for (int nt = 0; nt < 16; ++nt)
#pragma unroll
                for (int j = 0; j < 4; ++j) { const float e = __builtin_amdgcn_exp2f((s[nt][j] - mx) * sc); s[nt][j] = e; sum += e; }
            sum += __shfl_xor(sum, 16); sum += __shfl_xor(sum, 32);
            inv[gi] = 1.0f / sum;
#pragma unroll
            for (int ks = 0; ks < 8; ++ks) { u32x4 w; w.x = pk(s[2 * ks][0], s[2 * ks][1]); w.y = pk(s[2 * ks][2], s[2 * ks][3]); w.z = pk(s[2 * ks + 1][0], s[2 * ks + 1][1]); w.w = pk(s[2 * ks + 1][2], s[2 * ks + 1][3]); pf[gi][ks] = __builtin_bit_cast(bf16x8, w); }
        }
    }
    __syncthreads();
    attn_fill<false>(shm, Vg, 256);
    __syncthreads();
#pragma unroll
    for (int gi = 0; gi < 2; ++gi) {
        const int grp = wid + 8 * gi;
        if (grp < ngroups) {
            bf16_t* og = ob + (size_t)(grp * 16 + fr) * DMIX + 4 * fq;
#pragma unroll
            for (int dt = 0; dt < 16; ++dt) {
                f32x4 o = (f32x4){0.f, 0.f, 0.f, 0.f};
#pragma unroll
                for (int ks = 0; ks < 8; ++ks) { const bf16x8 vf = *(const bf16x8*)(shm + dt * 8192 + rbv + (ks >> 2) * 256 + offs[ks & 3]); o = __builtin_amdgcn_mfma_f32_16x16x32_bf16(vf, pf[gi][ks], o, 0, 0, 0); }
                u32x2 w; w.x = pk(o[0] * inv[gi], o[1] * inv[gi]); w.y = pk(o[2] * inv[gi], o[3] * inv[gi]);
                *(u32x2*)(og + dt * 16) = w;
            }
        }
    }
}
__device__ __forceinline__ void attn_phase(const Params& p, int layer, int chunk, bool has_s, const bf16_t* proj, int ldp, bf16_t* ycat, unsigned char* shm) {
    const int rows0 = chunk * CH;
    const bf16_t* Kb = (const bf16_t*)(p.ws + WS_KB); const bf16_t* Vt = (const bf16_t*)(p.ws + WS_VT);
    const int np = (CH / 256) * 4, nit = np + (has_s ? 32 : 0);
    for (int it = blockIdx.x; it < nit; it += gridDim.x) {
        int hd, t0, bb, ng;
        if (it < np) { hd = it & 3; t0 = rows0 + (it >> 2) * 256; bb = 8 + chunk; ng = 16; }
        else { const int i2 = it - np; hd = i2 & 3; bb = i2 >> 2; t0 = NPROMPT + bb * 32; ng = 2; }
        const int bbi = layer * 10 + bb; const size_t lr = (size_t)lrow(t0, rows0);
        attn_block(proj + lr * ldp + (ldp - 1024) + hd * 256, ldp, Kb + (size_t)bbi * 262144 + hd * 256, Vt + ((size_t)bbi * 4 + hd) * 65536, ycat + (size_t)t0 * DMIX + D + hd * 256, ng, shm);
    }
    __syncthreads();
}

__device__ __forceinline__ void stats_phase(const Params& p, const bf16_t* proj, int chunk, bool has_s) {
    const int lane = otid() & 63, wid = otid() >> 6, rows0 = chunk * CH;
    float* stats = (float*)(p.ws + WS_STATS);
    const int nr = CH + (has_s ? NSAMP : 0);
    for (int i = blockIdx.x * 8 + wid; i < nr; i += gridDim.x * 8) {
        const int row = i < CH ? rows0 + i : NPROMPT + (i - CH);
        const bf16_t* q = proj + (size_t)lrow(row, rows0) * NB + D;
        float v[32]; float s = 0.f;
#pragma unroll
        for (int k = 0; k < 4; ++k) { float f[8]; unpack8(*(const u32x4*)(q + (k * 64 + lane) * 8), f);
#pragma unroll
            for (int j = 0; j < 8; ++j) { v[k * 8 + j] = f[j]; s += f[j]; } }
#pragma unroll
        for (int o = 32; o >= 1; o >>= 1) s += __shfl_xor(s, o);
        const float mean = s * (1.0f / 2048.0f); float qq = 0.f;
#pragma unroll
        for (int j = 0; j < 32; ++j) { const float d = v[j] - mean; qq += d * d; }
#pragma unroll
        for (int o = 32; o >= 1; o >>= 1) qq += __shfl_xor(qq, o);
        if (lane == 0) { stats[(size_t)row * 2] = mean; stats[(size_t)row * 2 + 1] = rsqrtf(qq * (1.0f / 2048.0f) + EPS); }
    }
}
constexpr int VS = 136;
__device__ __forceinline__ void gmlp_item(const Params& p, const bf16_t* proj, bf16_t* ycat, int rows0, int row0, int nrows, int g, int sb, unsigned char* shm) {
    const int tid = otid(), lane = tid & 63, wid = tid >> 6, fr = lane & 15, fq = lane >> 4;
    bf16_t* vT = (bf16_t*)shm;
    const float* stats = (const float*)(p.ws + WS_STATS);
    {
        const int d0 = (tid & 31) * 8, c0 = g * 256 + d0;
        float gam[8], bet[8];
#pragma unroll
        for (int j = 0; j < 8; ++j) { gam[j] = p.in[I_GNG][c0 + j]; bet[j] = p.in[I_GNB][c0 + j]; }
#pragma unroll 2
        for (int i = 0; i < 8; ++i) {
            const int s = (tid >> 5) + 16 * i;
            float vn[8];
            if (s < nrows) {
                const int r = row0 + s;
                float f[8]; unpack8(*(const u32x4*)(proj + (size_t)lrow(r, rows0) * NB + D + c0), f);
                const float mean = stats[(size_t)r * 2], rstd = stats[(size_t)r * 2 + 1];
#pragma unroll
                for (int j = 0; j < 8; ++j) vn[j] = (f[j] - mean) * rstd * gam[j] + bet[j];
                if (sb >= 0) { float* o = p.out + O_GVS + ((size_t)(sb * 32 + s)) * D + c0; *(f32x4*)o = (f32x4){vn[0], vn[1], vn[2], vn[3]}; *(f32x4*)(o + 4) = (f32x4){vn[4], vn[5], vn[6], vn[7]}; }
            } else {
#pragma unroll
                for (int j = 0; j < 8; ++j) vn[j] = 0.f;
            }
#pragma unroll
            for (int j = 0; j < 4; ++j) { const unsigned w = pk(vn[2 * j], vn[2 * j + 1]); const int sx = s ^ (((tid & 31) & 15) << 3);
                vT[(d0 + 2 * j) * VS + sx] = (bf16_t)(w & 0xffffu); vT[(d0 + 2 * j + 1) * VS + sx] = (bf16_t)(w >> 16); }
        }
    }
    __syncthreads();
    const bf16_t* Wm = (const bf16_t*)(p.ws + WS_WM) + (size_t)g * 16384;
    const int ntt = nrows >> 4, dbase = wid * 32;
    f32x4 acc[2][8];
#pragma unroll
    for (int dt = 0; dt < 2; ++dt)
#pragma unroll
        for (int tt = 0; tt < 8; ++tt) acc[dt][tt] = (f32x4){0.f, 0.f, 0.f, 0.f};
#pragma unroll
    for (int ks = 0; ks < 4; ++ks) {
        if (ks * 32 < nrows) {
            bf16x8 af[2];
#pragma unroll
            for (int dt = 0; dt < 2; ++dt) { const int d = dbase + dt * 16 + fr; af[dt] = *(const bf16x8*)(vT + d * VS + ((ks * 32 + fq * 8) ^ (((d >> 3) & 15) << 3))); }
#pragma unroll
            for (int tt = 0; tt < 8; ++tt) {
                if (tt < ntt && ks * 32 <= tt * 16 + 15) {
                    const bf16x8 bw = *(const bf16x8*)(Wm + (size_t)(tt * 16 + fr) * 128 + ks * 32 + fq * 8);
#pragma unroll
                    for (int dt = 0; dt < 2; ++dt) acc[dt][tt] = __builtin_amdgcn_mfma_f32_16x16x32_bf16(af[dt], bw, acc[dt][tt], 0, 0, 0);
                }
            }
        }
    }
    const float* gb = p.in[I_GBIAS] + g * 128;
#pragma unroll
    for (int tt = 0; tt < 8; ++tt) {
        if (tt < ntt) {
            const int t = tt * 16 + fr; const size_t lr = (size_t)lrow(row0 + t, rows0);
            const float bias = gb[t];
#pragma unroll
            for (int dt = 0; dt < 2; ++dt) {
                const int dc = g * 256 + dbase + dt * 16 + 4 * fq;
                const u32x2 uu = *(const u32x2*)(proj + lr * NB + dc);
                const f32x4 a = acc[dt][tt];
                u32x2 w; w.x = pk(bf_lo(uu.x) * (a[0] + bias), bf_hi(uu.x) * (a[1] + bias)); w.y = pk(bf_lo(uu.y) * (a[2] + bias), bf_hi(uu.y) * (a[3] + bias));
                *(u32x2*)(ycat + (size_t)(row0 + t) * DMIX + dc) = w;
            }
        }
    }
    __syncthreads();
}
__device__ __forceinline__ void gmlp_phase(const Params& p, const bf16_t* proj, bf16_t* ycat, int chunk, bool has_s, unsigned char* shm) {
    const int rows0 = chunk * CH;
    const int nit = (CH / 128) * 8 + (has_s ? 64 : 0);
    for (int it = blockIdx.x; it < nit; it += gridDim.x) {
        if (it < (CH / 128) * 8) gmlp_item(p, proj, ycat, rows0, rows0 + (it >> 3) * 128, 128, it & 7, -1, shm);
        else { const int i2 = it - (CH / 128) * 8, b = i2 >> 3; gmlp_item(p, proj, ycat, rows0, NPROMPT + b * 32, 32, i2 & 7, b, shm); }
    }
}

__device__ __forceinline__ void ffn_rows(const Params& p, int layer, const bf16_t* z, bf16_t* h, int rows0, int r0, int r1, int seq0, int seq1, const float* prev, float* state_out, int c0) {
    const float* cw = p.in[I_FCW] + (size_t)layer * 3 * DFF2; const float* cb = p.in[I_FCB] + (size_t)layer * DFF2;
    float wa[3][8], wg[3][8], ba[8], bg[8], am2[8], am1[8], gm2[8], gm1[8];
    const int za_off = (c0 >> 7) * 256 + (c0 & 127), zg_off = za_off + 128;
#pragma unroll
    for (int k = 0; k < 3; ++k)
#pragma unroll
        for (int i = 0; i < 8; ++i) { wa[k][i] = cw[k * DFF2 + c0 + i]; wg[k][i] = cw[k * DFF2 + DFF + c0 + i]; }
#pragma unroll
    for (int i = 0; i < 8; ++i) { ba[i] = cb[c0 + i]; bg[i] = cb[DFF + c0 + i]; }
    {
        const int ra = r0 - 2, rb = r0 - 1;
        if (ra >= seq0) { const bf16_t* q = z + (size_t)lrow(ra, rows0) * DFF2; unpack8(*(const u32x4*)(q + za_off), am2); unpack8(*(const u32x4*)(q + zg_off), gm2); }
        else {
#pragma unroll
            for (int i = 0; i < 8; ++i) { am2[i] = prev ? prev[(size_t)(ra - seq0 + 2) * DFF2 + c0 + i] : 0.f; gm2[i] = prev ? prev[(size_t)(ra - seq0 + 2) * DFF2 + DFF + c0 + i] : 0.f; } }
        if (rb >= seq0) { const bf16_t* q = z + (size_t)lrow(rb, rows0) * DFF2; unpack8(*(const u32x4*)(q + za_off), am1); unpack8(*(const u32x4*)(q + zg_off), gm1); }
        else {
#pragma unroll
            for (int i = 0; i < 8; ++i) { am1[i] = prev ? prev[(size_t)(rb - seq0 + 2) * DFF2 + c0 + i] : 0.f; gm1[i] = prev ? prev[(size_t)(rb - seq0 + 2) * DFF2 + DFF + c0 + i] : 0.f; } }
    }
#pragma unroll 4
    for (int r = r0; r < r1; ++r) {
        const bf16_t* q = z + (size_t)lrow(r, rows0) * DFF2;
        float a[8], g[8], o[8];
        unpack8(*(const u32x4*)(q + za_off), a); unpack8(*(const u32x4*)(q + zg_off), g);
#pragma unroll
        for (int i = 0; i < 8; ++i) {
            const float ca = wa[0][i] * am2[i] + wa[1][i] * am1[i] + wa[2][i] * a[i] + ba[i];
            const float cg = wg[0][i] * gm2[i] + wg[1][i] * gm1[i] + wg[2][i] * g[i] + bg[i];
            o[i] = ca * cg * __builtin_amdgcn_rcpf(1.0f + __builtin_amdgcn_exp2f(-1.44269504089f * cg));
            am2[i] = am1[i]; am1[i] = a[i]; gm2[i] = gm1[i]; gm1[i] = g[i];
        }
        *(u32x4*)(h + (size_t)r * DFF + c0) = pack8(o);
        if (r >= seq1 - 2) { float* so = state_out + (size_t)(r - (seq1 - 2)) * DFF2 + c0;
            *(f32x4*)so = (f32x4){a[0], a[1], a[2], a[3]}; *(f32x4*)(so + 4) = (f32x4){a[4], a[5], a[6], a[7]};
            *(f32x4*)(so + DFF) = (f32x4){g[0], g[1], g[2], g[3]}; *(f32x4*)(so + DFF + 4) = (f32x4){g[4], g[5], g[6], g[7]}; }
    }
}
__device__ __forceinline__ void ffn_mid_phase(const Params& p, int layer, const bf16_t* z, bf16_t* h, int chunk, bool has_s) {
    const int tid = otid(), lane = tid & 63, wid = tid >> 6, rows0 = chunk * CH;
    if (!has_s) return;
    const int nw = gridDim.x * 8;
    for (int i2 = nw - 1 - (int)(blockIdx.x * 8 + wid); i2 < 8 * 8 * 11; i2 += nw) {
        const int cbk = i2 % 11, rb = i2 / 11, b = rb >> 3, s0 = NPROMPT + b * 32, r0 = s0 + (rb & 7) * 4;
        ffn_rows(p, layer, z, h, rows0, r0, r0 + 4, s0, s0 + 32, p.in[I_CFC] + (size_t)((layer * 8 + b) * 2) * DFF2, p.out + O_FCS + (size_t)((layer * 8 + b) * 2) * DFF2, (cbk * 64 + lane) * 8);
    }
}
__device__ __forceinline__ void ffn_fix_phase(const Params& p, int layer, const float* halo, bf16_t* h) {
    const int tid = otid(), lane = tid & 63, wid = tid >> 6;
    const float* cw = p.in[I_FCW] + (size_t)layer * 3 * DFF2; const float* cb = p.in[I_FCB] + (size_t)layer * DFF2;
    for (int it = blockIdx.x * 8 + wid; it < (NPROMPT / 64) * 11; it += gridDim.x * 8) {
        const int blk = it / 11, c0 = ((it % 11) * 64 + lane) * 8, bseq = blk & (CH / 64 - 1), chunk = blk / (CH / 64);
        float o0[8], o1[8];
#pragma unroll
        for (int part = 0; part < 2; ++part) {
            const int cc = part * DFF + c0;
            float w0[8], w1[8], w2[8], bb[8], z0[8], z1[8], zm1[8], zm2[8];
#pragma unroll
            for (int i = 0; i < 8; ++i) { w0[i] = cw[cc + i]; w1[i] = cw[DFF2 + cc + i]; w2[i] = cw[2 * DFF2 + cc + i]; bb[i] = cb[cc + i]; }
            const float* hp = halo + (size_t)blk * 4 * DFF2 + cc;
#pragma unroll
            for (int i = 0; i < 8; ++i) { z0[i] = hp[i]; z1[i] = hp[DFF2 + i]; zm2[i] = bseq > 0 ? hp[i - 2 * DFF2] : 0.f; zm1[i] = bseq > 0 ? hp[i - DFF2] : 0.f; }
#pragma unroll
            for (int i = 0; i < 8; ++i) {
                const float c_0 = w0[i] * zm2[i] + w1[i] * zm1[i] + w2[i] * z0[i] + bb[i];
                const float c_1 = w0[i] * zm1[i] + w1[i] * z0[i] + w2[i] * z1[i] + bb[i];
                if (part == 0) { o0[i] = c_0; o1[i] = c_1; }
                else { o0[i] = o0[i] * c_0 * __builtin_amdgcn_rcpf(1.0f + __builtin_amdgcn_exp2f(-1.44269504089f * c_0)); o1[i] = o1[i] * c_1 * __builtin_amdgcn_rcpf(1.0f + __builtin_amdgcn_exp2f(-1.44269504089f * c_1)); }
            }
            if (bseq == CH / 64 - 1) {
                float* so = p.out + O_FCP + (size_t)((layer * 2 + chunk) * 2) * DFF2 + cc;
#pragma unroll
                for (int i = 0; i < 8; ++i) { so[i] = hp[2 * DFF2 + i]; so[DFF2 + i] = hp[3 * DFF2 + i]; }
            }
        }
        *(u32x4*)(h + (size_t)(blk * 64) * DFF + c0) = pack8(o0);
        *(u32x4*)(h + (size_t)(blk * 64 + 1) * DFF + c0) = pack8(o1);
    }
}

__device__ __forceinline__ void final_phase(const Params& p) {
    const int tid = otid(), lane = tid & 63, wid = tid >> 6;
    const float* ss = (const float*)(p.ws + WS_SS); const float* gf = p.in[I_GFIN]; const bf16_t* xb = (const bf16_t*)(p.ws + WS_XB);
    for (int row = blockIdx.x * 8 + wid; row < NROWS; row += gridDim.x * 8) {
        float s = lane < 32 ? ss[(size_t)row * 32 + lane] : 0.f;
#pragma unroll
        for (int o = 32; o >= 1; o >>= 1) s += __shfl_xor(s, o);
        const float rs = rsqrtf(s * (1.0f / 2048.0f) + EPS);
        const bf16_t* x = xb + (size_t)row * D; float* y = p.out + (size_t)row * D;
#pragma unroll
        for (int k = 0; k < 4; ++k) { const int c = (k * 64 + lane) * 8; float f[8]; unpack8(*(const u32x4*)(x + c), f);
            const f32x4 g0 = *(const f32x4*)(gf + c), g1 = *(const f32x4*)(gf + c + 4);
            *(f32x4*)(y + c) = (f32x4){f[0], f[1], f[2], f[3]} * rs * g0; *(f32x4*)(y + c + 4) = (f32x4){f[4], f[5], f[6], f[7]} * rs * g1; }
    }
}

__global__ void __launch_bounds__(512, 2) fwd_kernel(Params p) {
    extern __shared__ __attribute__((aligned(16))) unsigned char shm[];
    cg::grid_group grid = cg::this_grid();
    LAS unsigned char* lds0 = (LAS unsigned char*)shm;
    {
        volatile LAS unsigned* st = (volatile LAS unsigned*)(lds0 + pg8::STAGE_BYTES);
        if (threadIdx.x < 2) st[threadIdx.x] = 0u;
        __syncthreads();
    }
    const XcdBarrier xbar = xcd_barrier_post((unsigned*)(p.ws + WS_BAR), (volatile LAS unsigned*)(lds0 + pg8::STAGE_BYTES));
#define GSYNC() do { for (int rep_ = 0; rep_ < REP_SYNC; ++rep_) xcd_barrier(xbar); } while (0)
    PG8_LAS unsigned char* lds = (PG8_LAS unsigned char*)shm;
    unsigned char* ws = p.ws;
    const int G = gridDim.x, bid = blockIdx.x;
    bf16_t* xb = (bf16_t*)(ws + WS_XB); float* ss = (float*)(ws + WS_SS);
    bf16_t* proj = (bf16_t*)(ws + WS_BIG + BIG_PROJ); bf16_t* ycat = (bf16_t*)(ws + WS_BIG + BIG_YCAT);
    bf16_t* hb = (bf16_t*)(ws + WS_BIG + BIG_H); float* halo = (float*)(ws + WS_BIG + BIG_HALO);
    bf16_t* zb = (bf16_t*)(ws + WS_BIG + BIG_ZS) - (size_t)CH * DFF2;

    for (int rep = 0; rep < REP_PREP; ++rep) prep_phase(p, shm);
    if (p.ws == nullptr) grid.sync();
    GSYNC();

#pragma unroll 1
    for (int layer = 0; layer < 2; ++layer) {
#pragma unroll 1
        for (int chunk = 0; chunk < 2; ++chunk) {
            const int rows0 = chunk * CH; const bool has_s = chunk == 0;
            {
                const int N1 = layer ? NB : NA; const bf16_t* W1 = (const bf16_t*)(ws + (layer ? WS_WINB : WS_WINA));
                const OpScale op{ss, proj, N1, rows0, layer ? 2 * D : 0};
                pg8::Gemm g{xb + (size_t)rows0 * D, W1, CH, N1, D}; pg8::StaticOrder S; S.init(CH, N1, G, bid);
                EpiG<OpScale> E{op, rows0};
                pg8::gemm_phase<EpiG<OpScale>, pg8::StaticOrder, GEMM_ALIGN, GEMM_SP2>(lds, g, S, E);
                if (has_s) small_gemm(xb + (size_t)NPROMPT * D, D, W1, NSAMP, N1, D, op, NPROMPT, shm);
                if (chunk == 0 && layer == 0) {
                    const OpMemKV om{(const float*)(ws + WS_SSM), p.out + O_MKP, p.out + O_MVP, (bf16_t*)(ws + WS_KB), (bf16_t*)(ws + WS_VT)};
                    small_gemm((const bf16_t*)(ws + WS_MEMB), D, (const bf16_t*)(ws + WS_WMEM), 512, 4096, D, om, 0, shm);
                }
            }
            GSYNC();
            if (layer == 0) {
                mixa_phase(p, proj, ycat, chunk, has_s);
                attn_phase(p, 0, chunk, has_s, proj, NA, ycat, shm);
            }
            else {
                stats_phase(p, proj, chunk, has_s);
                GSYNC();
                gmlp_phase(p, proj, ycat, chunk, has_s, shm);
                attn_phase(p, 1, chunk, has_s, proj, NB, ycat, shm);
            }
            GSYNC();
        }
        {
            const bf16_t* W = (const bf16_t*)(ws + WS_WOUT) + (size_t)layer * D * DMIX;
            const OpResid opp{xb, ss};
            const OpResid ops{xb, ss};
            pg8::Gemm g{ycat, W, NPROMPT, D, DMIX}; pg8::StaticOrder S; S.init(NPROMPT, D, G, bid);
            EpiG<OpResid> E{opp, 0};
            pg8::gemm_phase<EpiG<OpResid>, pg8::StaticOrder, GEMM_ALIGN, GEMM_SP2>(lds, g, S, E);
            small_gemm(ycat + (size_t)NPROMPT * DMIX, DMIX, W, NSAMP, D, DMIX, ops, NPROMPT, shm);
        }
        GSYNC();
        {
            const bf16_t* W = (const bf16_t*)(ws + WS_WUP) + (size_t)layer * D * DFF2;
            const OpScale op{ss, zb, DFF2, 0, 0};
            pg8::Gemm g{xb, W, NPROMPT, DFF2, D}; pg8::StaticOrder S; S.init(NPROMPT, DFF2, G, bid);
            const EpiFfn E{ss, p.in[I_FCW] + (size_t)layer * 3 * DFF2, p.in[I_FCB] + (size_t)layer * DFF2, hb, halo, 0};
            pg8::gemm_phase<EpiFfn, pg8::StaticOrder, GEMM_ALIGN, GEMM_SP2>(lds, g, S, E);
            small_gemm(xb + (size_t)NPROMPT * D, D, W, NSAMP, DFF2, D, op, NPROMPT, shm);
        }
        GSYNC();
        ffn_fix_phase(p, layer, halo, hb);
        ffn_mid_phase(p, layer, zb, hb, 0, true);
        GSYNC();
        {
            const bf16_t* W = (const bf16_t*)(ws + WS_WDOWN) + (size_t)layer * D * DFF;
            const OpResid op{xb, ss};
            pg8::Gemm g{hb, W, NPROMPT, D, DFF}; pg8::StaticOrder S; S.init(NPROMPT, D, G, bid);
            EpiG<OpResid> E{op, 0};
            pg8::gemm_phase<EpiG<OpResid>, pg8::StaticOrder, GEMM_ALIGN, GEMM_SP2>(lds, g, S, E);
            small_gemm(hb + (size_t)NPROMPT * DFF, DFF, W, NSAMP, D, DFF, op, NPROMPT, shm);
        }
        GSYNC();
    }
    final_phase(p);
}

extern "C" void kernel_launch(void* const* d_in, const int* in_sizes, int n_in, void* d_out, int out_size, void* d_ws, size_t ws_size, hipStream_t stream) {
    static int grid = 0;
    if (grid == 0) {
        if (n_in != 25 || ws_size < WS_END) { fprintf(stderr, "kernel_launch: unexpected shapes: n_in %d ws %zu (need %zu)\n", n_in, ws_size, (size_t)WS_END); grid = -1; return; }
        int dev = 0, cus = 0, per_cu = 0;
        hipGetDevice(&dev);
        hipDeviceGetAttribute(&cus, hipDeviceAttributeMultiprocessorCount, dev);
        if (hipFuncSetAttribute((const void*)fwd_kernel, hipFuncAttributeMaxDynamicSharedMemorySize, LDS_BYTES) != hipSuccess) { fprintf(stderr, "kernel_launch: hipFuncSetAttribute failed\n"); }
        if (hipOccupancyMaxActiveBlocksPerMultiprocessor(&per_cu, (const void*)fwd_kernel, 512, LDS_BYTES) != hipSuccess || per_cu < 1) { fprintf(stderr, "kernel_launch: occupancy query says %d\n", per_cu); per_cu = 1; }
        (void)hipGetLastError();
        grid = cus;
    }
    if (grid < 0) return;
    if (hipMemsetAsync((char*)d_ws + WS_BAR, 0, 16384, stream) != hipSuccess) { fprintf(stderr, "kernel_launch: memset of the barrier words failed\n"); return; }
    Params p{};
    for (int i = 0; i < 25; ++i) p.in[i] = (const float*)d_in[i];
    p.out = (float*)d_out; p.ws = (unsigned char*)d_ws;
    void* args[] = {&p};
    hipError_t e = hipLaunchCooperativeKernel((const void*)fwd_kernel, dim3(grid), dim3(512), args, LDS_BYTES, stream);
    if (e != hipSuccess) fprintf(stderr, "kernel_launch: cooperative launch failed: %s (grid %d)\n", hipGetErrorString(e), grid);
}
```
